# Optimizing an MI355X kernel written in HIP

```python
import numpy as np
import jax
import jax.numpy as jnp
from jax import lax

D_MODEL = 1024
BATCH = 8
SEQ = 4096
DEPTH = 2

HEAD_DIM = 64
ROPE_THETA = 10000.0
RMS_EPS = 1e-6
GN_EPS = 1e-5
RWKV_LN_EPS = 64e-5
D_FF = 2816
N_BRANCH = 4
BAND_BLOCK = 128
NEG_INF = -1e30
FORCED_SCORE = 1e9

NSA_HEADS = 4
NSA_KV_DIM = HEAD_DIM
NSA_CMP_LEN = 32
NSA_CMP_STRIDE = 16
NSA_CMP_HIDDEN = 256
NSA_SEL_BLOCK = 64
NSA_TOP_N = 16
NSA_WINDOW = 512

RET_HEADS = 4
RET_DK = HEAD_DIM
RET_DV = 2 * HEAD_DIM
RET_CHUNK = 128

RWKV_HEADS = 4
RWKV_W_LORA = 64
RWKV_A_LORA = 64
RWKV_G_LORA = 128

SWA_HEADS = 4
SWA_KV_HEADS = 2
SWA_WINDOW = 128

NSA_WIDTH = NSA_HEADS * HEAD_DIM
RET_WIDTH = RET_HEADS * RET_DV
RWKV_WIDTH = RWKV_HEADS * HEAD_DIM
SWA_WIDTH = SWA_HEADS * HEAD_DIM
RWKV_MIX_WIDTH = 3 * RWKV_WIDTH + RWKV_W_LORA + RWKV_A_LORA + RWKV_G_LORA

kernel_name = 'hybrid_nsa_retnet_rwkv7_swa_macaron'


def _column_layout():
    spec = (
        ('nsa_q', NSA_WIDTH), ('nsa_k_cmp', NSA_KV_DIM), ('nsa_v_cmp', NSA_KV_DIM),
        ('nsa_k_slc', NSA_KV_DIM), ('nsa_v_slc', NSA_KV_DIM),
        ('nsa_k_win', NSA_KV_DIM), ('nsa_v_win', NSA_KV_DIM), ('nsa_gate', 3 * NSA_HEADS),
        ('ret_q', RET_HEADS * RET_DK), ('ret_k', RET_HEADS * RET_DK),
        ('ret_v', RET_WIDTH), ('ret_g', RET_WIDTH),
        ('rwkv', RWKV_MIX_WIDTH),
        ('swa_q', SWA_WIDTH), ('swa_k', SWA_KV_HEADS * HEAD_DIM), ('swa_v', SWA_KV_HEADS * HEAD_DIM),
        ('branch_gate', N_BRANCH * D_MODEL),
    )
    layout, start = {}, 0
    for name, width in spec:
        layout[name] = (start, start + width)
        start += width
    return layout, start


def _cols(p, layout, name):
    s, e = layout[name]
    return p[..., s:e]


def rms_norm(x, g):
    xf = x.astype(jnp.float32)
    y = xf * lax.rsqrt(jnp.mean(xf * xf, axis=-1, keepdims=True) + RMS_EPS)
    return (y * g.astype(jnp.float32)).astype(x.dtype)


def swiglu(x, w_gate, w_up, w_down):
    return (jax.nn.silu(x @ w_gate) * (x @ w_up)) @ w_down


def rope(t, pos):
    d = t.shape[-1]
    half = d // 2
    inv_freq = jnp.power(ROPE_THETA, -jnp.arange(half, dtype=jnp.float32) * 2.0 / d)
    ang = pos.astype(jnp.float32)[:, None] * inv_freq[None, :]
    cos = jnp.cos(ang)[:, None, :]
    sin = jnp.sin(ang)[:, None, :]
    tf = t.astype(jnp.float32)
    t1, t2 = tf[..., :half], tf[..., half:]
    return jnp.concatenate([t1 * cos - t2 * sin, t2 * cos + t1 * sin], axis=-1).astype(t.dtype)


def masked_softmax(s, mask):
    s = jnp.where(mask, s.astype(jnp.float32), NEG_INF)
    m = jnp.max(s, axis=-1, keepdims=True)
    p = jnp.exp(s - m) * mask
    return p / jnp.maximum(jnp.sum(p, axis=-1, keepdims=True), 1e-30)


def banded_attention(q, k, v, window, sinks=None):
    B, S, Hk, G, D = q.shape
    blk = BAND_BLOCK
    nb = S // blk
    n_prev = -(-(window - 1) // blk)
    pad = n_prev * blk
    n_keys = (n_prev + 1) * blk
    kp = jnp.pad(k, ((0, 0), (pad, 0), (0, 0), (0, 0))).reshape(B, nb + n_prev, blk, Hk, D)
    vp = jnp.pad(v, ((0, 0), (pad, 0), (0, 0), (0, 0))).reshape(B, nb + n_prev, blk, Hk, D)
    kb = jnp.concatenate([kp[:, j:j + nb] for j in range(n_prev + 1)], axis=2)
    vb = jnp.concatenate([vp[:, j:j + nb] for j in range(n_prev + 1)], axis=2)
    qb = q.reshape(B, nb, blk, Hk, G, D)
    s = jnp.einsum('bnqhgd,bnkhd->bnhgqk', qb, kb).astype(jnp.float32) * (D ** -0.5)
    qpos = jnp.arange(nb)[:, None] * blk + jnp.arange(blk)[None, :]
    kpos = jnp.arange(nb)[:, None] * blk - pad + jnp.arange(n_keys)[None, :]
    diff = qpos[:, :, None] - kpos[:, None, :]
    mask = ((diff >= 0) & (diff < window) & (kpos[:, None, :] >= 0))[None, :, None, None]
    s = jnp.where(mask, s, NEG_INF)
    m = jnp.max(s, axis=-1, keepdims=True)
    if sinks is not None:
        sk = sinks.astype(jnp.float32)[None, None, :, :, None, None]
        m = jnp.maximum(m, sk)
    p = jnp.exp(s - m) * mask
    denom = jnp.sum(p, axis=-1, keepdims=True)
    if sinks is not None:
        denom = denom + jnp.exp(sk - m)
    p = (p / denom).astype(v.dtype)
    o = jnp.einsum('bnhgqk,bnkhd->bnqhgd', p, vb)
    return o.reshape(B, S, Hk * G * D)


def nsa_mixer(q, k_cmp, v_cmp, k_slc, v_slc, k_win, v_win, gate_logits,
              pos_k, pos_v, ck_w1, ck_w2, cv_w1, cv_w2, pos):
    B, S, H, D = q.shape
    scale = D ** -0.5
    n_cmp = (S - NSA_CMP_LEN) // NSA_CMP_STRIDE + 1
    cmp_start = jnp.arange(n_cmp) * NSA_CMP_STRIDE
    cmp_idx = cmp_start[:, None] + jnp.arange(NSA_CMP_LEN)[None, :]

    def compress(t, pos_emb, w1, w2):
        blocks = (t[:, cmp_idx] + pos_emb).reshape(B, n_cmp, NSA_CMP_LEN * D)
        return jax.nn.gelu(blocks @ w1) @ w2

    kc = compress(k_cmp, pos_k, ck_w1, ck_w2)
    vc = compress(v_cmp, pos_v, cv_w1, cv_w2)
    cmp_mask = (cmp_start + NSA_CMP_LEN - 1)[None, :] <= pos[:, None]
    p_cmp = masked_softmax(jnp.einsum('bshd,bnd->bhsn', q, kc) * scale, cmp_mask)
    o_cmp = jnp.einsum('bhsn,bnd->bshd', p_cmp.astype(vc.dtype), vc)
    n_sel = S // NSA_SEL_BLOCK
    sel_start = jnp.arange(n_sel) * NSA_SEL_BLOCK
    overlap = ((cmp_start[:, None] <= sel_start[None, :] + NSA_SEL_BLOCK - 1)
               & (cmp_start[:, None] + NSA_CMP_LEN - 1 >= sel_start[None, :])).astype(jnp.float32)
    importance = jnp.einsum('bhsn,nj->bsj', p_cmp, overlap)
    cur = pos // NSA_SEL_BLOCK
    blk_id = jnp.arange(n_sel)
    valid = blk_id[None, :] <= cur[:, None]
    forced = (blk_id[None, :] == 0) | (blk_id[None, :] == cur[:, None]) | (blk_id[None, :] == cur[:, None] - 1)
    score = jnp.where(forced, FORCED_SCORE, jnp.where(valid, importance, -FORCED_SCORE))
    n_top = min(NSA_TOP_N, n_sel)
    _, sel = lax.top_k(score, n_top)
    sel_valid = sel <= cur[None, :, None]
    q_rot = rope(q, pos)
    k_slc = rope(k_slc[:, :, None], pos)[:, :, 0]
    k_win = rope(k_win[:, :, None], pos)[:, :, 0]
    blk = BAND_BLOCK
    nqb = S // blk

    def sel_block(args):
        qb, selb, validb, posb = args
        tok4 = selb[..., None] * NSA_SEL_BLOCK + jnp.arange(NSA_SEL_BLOCK)
        mask = (validb[..., None] & (tok4 <= posb[None, :, None, None])).reshape(B, blk, -1)
        tok = tok4.reshape(B, blk, -1)
        ks = jax.vmap(lambda t, i: t[i])(k_slc, tok)
        vs = jax.vmap(lambda t, i: t[i])(v_slc, tok)
        p = masked_softmax(jnp.einsum('bqhd,bqtd->bhqt', qb, ks) * scale, mask[:, None])
        return jnp.einsum('bhqt,bqtd->bqhd', p.astype(vs.dtype), vs)

    def to_blocks(t):
        return jnp.swapaxes(t.reshape((B, nqb, blk) + t.shape[2:]), 0, 1)

    o_slc = lax.map(sel_block, (to_blocks(q_rot), to_blocks(sel), to_blocks(sel_valid), pos.reshape(nqb, blk)))
    o_slc = jnp.swapaxes(o_slc, 0, 1).reshape(B, S, H, D)
    o_win = banded_attention(q_rot.reshape(B, S, 1, H, D), k_win[:, :, None], v_win[:, :, None],
                             NSA_WINDOW).reshape(B, S, H, D)
    g = jax.nn.sigmoid(gate_logits.reshape(B, S, H, 3))
    o = g[..., 0:1] * o_cmp + g[..., 1:2] * o_slc + g[..., 2:3] * o_win
    return o.reshape(B, S, H * D)


def retention_mixer(q, k, v, g_in, gn_g, pos):
    B, S, H, Dk = q.shape
    Dv = v.shape[-1]
    dt = q.dtype
    C = RET_CHUNK
    n = S // C
    log_g = jnp.log(1.0 - jnp.power(2.0, -5.0 - jnp.arange(H, dtype=jnp.float32)))
    q = rope(q, pos)
    k = rope(k, pos) * (Dk ** -0.5)
    qc = q.reshape(B, n, C, H, Dk)
    kc = k.reshape(B, n, C, H, Dk)
    vc = v.reshape(B, n, C, H, Dv)
    i = jnp.arange(C, dtype=jnp.float32)
    diff = i[:, None] - i[None, :]
    decay_mask = jnp.where(diff >= 0, jnp.exp(log_g[:, None, None] * jnp.maximum(diff, 0.0)), 0.0).astype(dt)
    zeta = jnp.exp(log_g[:, None] * (C - 1 - i)[None, :]).astype(dt)
    xi = jnp.exp(log_g[:, None] * (i + 1.0)[None, :]).astype(dt)
    g_chunk = jnp.exp(log_g * C).astype(dt)
    inner = jnp.einsum('bnchd,bnmhd->bnhcm', qc, kc) * decay_mask[None, None]
    o_inner = jnp.einsum('bnhcm,bnmhe->bnche', inner, vc)
    kv = jnp.einsum('bnmhd,hm,bnmhe->bnhde', kc, zeta, vc)

    def step(state, kv_n):
        return state * g_chunk[None, :, None, None] + kv_n, state

    _, r_prev = lax.scan(step, jnp.zeros((B, H, Dk, Dv), dt), jnp.swapaxes(kv, 0, 1))
    r_prev = jnp.swapaxes(r_prev, 0, 1)
    o_cross = jnp.einsum('bnchd,hc,bnhde->bnche', qc, xi, r_prev)
    o = (o_inner + o_cross).reshape(B, S, H, Dv).astype(jnp.float32)
    mu = jnp.mean(o, axis=-1, keepdims=True)
    var = jnp.mean(jnp.square(o - mu), axis=-1, keepdims=True)
    o = ((o - mu) * lax.rsqrt(var + GN_EPS)).reshape(B, S, H * Dv) * gn_g.astype(jnp.float32)
    return jax.nn.silu(g_in) * o.astype(dt)


def rwkv7_mixer(p, mu, w0, w2, a0, a2, g2, k_k, k_a, r_k, ln_g, ln_b):
    B, S, _ = p.shape
    H, N = RWKV_HEADS, HEAD_DIM
    f32 = lambda t: t.astype(jnp.float32)
    prev = jnp.pad(p, ((0, 0), (1, 0), (0, 0)))[:, :-1]
    xm = f32(p + mu * (prev - p))
    splits = [int(s) for s in np.cumsum([RWKV_WIDTH, RWKV_WIDTH, RWKV_WIDTH, RWKV_W_LORA, RWKV_A_LORA])]
    r, k, v, wl, al, gl = jnp.split(xm, splits, axis=-1)
    w = -jax.nn.softplus(-(f32(w0) + jnp.tanh(wl) @ f32(w2))) - 0.5
    decay = jnp.exp(-jnp.exp(w))
    a = jax.nn.sigmoid(f32(a0) + al @ f32(a2))
    g = jax.nn.sigmoid(gl) @ f32(g2)
    kk = (k * f32(k_k)).reshape(B, S, H, N)
    kk = kk / jnp.maximum(jnp.sqrt(jnp.sum(kk * kk, axis=-1, keepdims=True)), 1e-12)
    k = k * (1.0 + (a - 1.0) * f32(k_a))
    r, k, v, a, decay = [t.reshape(B, S, H, N) for t in (r, k, v, a, decay)]

    def step(state, inp):
        r_t, k_t, v_t, kk_t, a_t, w_t = inp
        sa = jnp.einsum('bhvk,bhk->bhv', state, -kk_t)
        state = (state * w_t[:, :, None, :] + sa[..., None] * (kk_t * a_t)[:, :, None, :]
                 + v_t[..., None] * k_t[:, :, None, :])
        return state, jnp.einsum('bhvk,bhk->bhv', state, r_t)

    xs = tuple(jnp.swapaxes(t, 0, 1) for t in (r, k, v, kk, a, decay))
    _, y = lax.scan(step, jnp.zeros((B, H, N, N), jnp.float32), xs)
    y = jnp.swapaxes(y, 0, 1)
    y_mu = jnp.mean(y, axis=-1, keepdims=True)
    y_var = jnp.mean(jnp.square(y - y_mu), axis=-1, keepdims=True)
    yn = ((y - y_mu) * lax.rsqrt(y_var + RWKV_LN_EPS)).reshape(B, S, H * N) * f32(ln_g) + f32(ln_b)
    bonus = (jnp.sum(r * k * f32(r_k), axis=-1, keepdims=True) * v).reshape(B, S, H * N)
    return ((yn + bonus) * g).astype(p.dtype)


def swa_sink_mixer(q, k, v, sinks, pos):
    B, S, Hq, D = q.shape
    Hkv = k.shape[2]
    G = Hq // Hkv
    q = rope(q, pos).reshape(B, S, Hkv, G, D)
    k = rope(k, pos)
    return banded_attention(q, k, v, SWA_WINDOW, sinks=sinks.reshape(Hkv, G))


def setup_inputs(seed: int = 0) -> dict:
    key = jax.random.key(seed)
    keys = iter(jax.random.split(key, 48))
    L = DEPTH
    _, n_cols = _column_layout()

    def dense(shape, fan_in):
        return jax.random.normal(next(keys), shape, jnp.float32) * (fan_in ** -0.5)

    def gain(shape):
        return 1.0 + 0.1 * jax.random.normal(next(keys), shape, jnp.float32)

    def small(shape, scale):
        return scale * jax.random.normal(next(keys), shape, jnp.float32)

    return {
        'x': jax.random.normal(next(keys), (BATCH, SEQ, D_MODEL), jnp.float32),
        'ffn1_pre_g': gain((L, D_MODEL)),
        'ffn1_post_g': gain((L, D_MODEL)),
        'ffn1_w_gate': dense((L, D_MODEL, D_FF), D_MODEL),
        'ffn1_w_up': dense((L, D_MODEL, D_FF), D_MODEL),
        'ffn1_w_down': dense((L, D_FF, D_MODEL), D_FF),
        'mix_pre_g': gain((L, D_MODEL)),
        'mix_post_g': gain((L, D_MODEL)),
        'w_in': dense((L, D_MODEL, n_cols), D_MODEL),
        'nsa_cmp_pos_k': small((L, NSA_CMP_LEN, NSA_KV_DIM), 0.5),
        'nsa_cmp_pos_v': small((L, NSA_CMP_LEN, NSA_KV_DIM), 0.5),
        'nsa_cmp_k_w1': dense((L, NSA_CMP_LEN * NSA_KV_DIM, NSA_CMP_HIDDEN), NSA_CMP_LEN * NSA_KV_DIM),
        'nsa_cmp_k_w2': dense((L, NSA_CMP_HIDDEN, NSA_KV_DIM), NSA_CMP_HIDDEN),
        'nsa_cmp_v_w1': dense((L, NSA_CMP_LEN * NSA_KV_DIM, NSA_CMP_HIDDEN), NSA_CMP_LEN * NSA_KV_DIM),
        'nsa_cmp_v_w2': dense((L, NSA_CMP_HIDDEN, NSA_KV_DIM), NSA_CMP_HIDDEN),
        'ret_gn_g': gain((L, RET_WIDTH)),
        'rwkv_mu': jax.random.uniform(next(keys), (L, RWKV_MIX_WIDTH), jnp.float32, 0.0, 1.0),
        'rwkv_w0': jax.random.uniform(next(keys), (L, RWKV_WIDTH), jnp.float32, -6.0, -1.0),
        'rwkv_w2': dense((L, RWKV_W_LORA, RWKV_WIDTH), RWKV_W_LORA),
        'rwkv_a0': small((L, RWKV_WIDTH), 0.1),
        'rwkv_a2': dense((L, RWKV_A_LORA, RWKV_WIDTH), RWKV_A_LORA),
        'rwkv_g2': dense((L, RWKV_G_LORA, RWKV_WIDTH), RWKV_G_LORA),
        'rwkv_k_k': 0.85 + small((L, RWKV_WIDTH), 0.1),
        'rwkv_k_a': gain((L, RWKV_WIDTH)),
        'rwkv_r_k': small((L, RWKV_HEADS, HEAD_DIM), 0.3),
        'rwkv_ln_g': gain((L, RWKV_WIDTH)),
        'rwkv_ln_b': small((L, RWKV_WIDTH), 0.02),
        'swa_sinks': small((L, SWA_HEADS), 1.0),
        'w_br_nsa': dense((L, NSA_WIDTH, D_MODEL), NSA_WIDTH),
        'w_br_ret': dense((L, RET_WIDTH, D_MODEL), RET_WIDTH),
        'w_br_rwkv': dense((L, RWKV_WIDTH, D_MODEL), RWKV_WIDTH),
        'w_br_swa': dense((L, SWA_WIDTH, D_MODEL), SWA_WIDTH),
        'w_out': dense((L, D_MODEL, D_MODEL), D_MODEL),
        'ffn2_pre_g': gain((L, D_MODEL)),
        'ffn2_post_g': gain((L, D_MODEL)),
        'ffn2_w_gate': dense((L, D_MODEL, D_FF), D_MODEL),
        'ffn2_w_up': dense((L, D_MODEL, D_FF), D_MODEL),
        'ffn2_w_down': dense((L, D_FF, D_MODEL), D_FF),
    }


def reference(x, ffn1_pre_g, ffn1_post_g, ffn1_w_gate, ffn1_w_up, ffn1_w_down,
              mix_pre_g, mix_post_g, w_in,
              nsa_cmp_pos_k, nsa_cmp_pos_v, nsa_cmp_k_w1, nsa_cmp_k_w2, nsa_cmp_v_w1, nsa_cmp_v_w2,
              ret_gn_g,
              rwkv_mu, rwkv_w0, rwkv_w2, rwkv_a0, rwkv_a2, rwkv_g2, rwkv_k_k, rwkv_k_a, rwkv_r_k,
              rwkv_ln_g, rwkv_ln_b,
              swa_sinks,
              w_br_nsa, w_br_ret, w_br_rwkv, w_br_swa, w_out,
              ffn2_pre_g, ffn2_post_g, ffn2_w_gate, ffn2_w_up, ffn2_w_down):
    B, S, D = x.shape
    pos = jnp.arange(S, dtype=jnp.int32)
    layout, _ = _column_layout()
    for l in range(DEPTH):
        f = swiglu(rms_norm(x, ffn1_pre_g[l]), ffn1_w_gate[l], ffn1_w_up[l], ffn1_w_down[l])
        x = x + 0.5 * rms_norm(f, ffn1_post_g[l])
        h = rms_norm(x, mix_pre_g[l])
        p = h @ w_in[l]
        c = lambda name: _cols(p, layout, name)
        y_nsa = nsa_mixer(
            c('nsa_q').reshape(B, S, NSA_HEADS, HEAD_DIM), c('nsa_k_cmp'), c('nsa_v_cmp'),
            c('nsa_k_slc'), c('nsa_v_slc'), c('nsa_k_win'), c('nsa_v_win'), c('nsa_gate'),
            nsa_cmp_pos_k[l], nsa_cmp_pos_v[l], nsa_cmp_k_w1[l], nsa_cmp_k_w2[l],
            nsa_cmp_v_w1[l], nsa_cmp_v_w2[l], pos)
        y_ret = retention_mixer(
            c('ret_q').reshape(B, S, RET_HEADS, RET_DK), c('ret_k').reshape(B, S, RET_HEADS, RET_DK),
            c('ret_v').reshape(B, S, RET_HEADS, RET_DV), c('ret_g'), ret_gn_g[l], pos)
        y_rwkv = rwkv7_mixer(c('rwkv'), rwkv_mu[l], rwkv_w0[l], rwkv_w2[l], rwkv_a0[l], rwkv_a2[l],
                             rwkv_g2[l], rwkv_k_k[l], rwkv_k_a[l], rwkv_r_k[l], rwkv_ln_g[l], rwkv_ln_b[l])
        y_swa = swa_sink_mixer(
            c('swa_q').reshape(B, S, SWA_HEADS, HEAD_DIM), c('swa_k').reshape(B, S, SWA_KV_HEADS, HEAD_DIM),
            c('swa_v').reshape(B, S, SWA_KV_HEADS, HEAD_DIM), swa_sinks[l], pos)
        gates = jax.nn.sigmoid(c('branch_gate').reshape(B, S, N_BRANCH, D))
        merged = (gates[:, :, 0] * (y_nsa @ w_br_nsa[l]) + gates[:, :, 1] * (y_ret @ w_br_ret[l])
                  + gates[:, :, 2] * (y_rwkv @ w_br_rwkv[l]) + gates[:, :, 3] * (y_swa @ w_br_swa[l]))
        x = x + rms_norm(merged @ w_out[l], mix_post_g[l])
        f = swiglu(rms_norm(x, ffn2_pre_g[l]), ffn2_w_gate[l], ffn2_w_up[l], ffn2_w_down[l])
        x = x + 0.5 * rms_norm(f, ffn2_post_g[l])
    return x
```

```cpp
#include <hip/hip_runtime.h>
#include <hip/hip_cooperative_groups.h>
#include <cstdio>
namespace cg = cooperative_groups;

#define LAS __attribute__((address_space(3)))
typedef unsigned short bf16_t;
typedef short bf16x8 __attribute__((ext_vector_type(8)));
typedef float f32x2 __attribute__((ext_vector_type(2)));
typedef float f32x4 __attribute__((ext_vector_type(4)));
typedef float f32x16 __attribute__((ext_vector_type(16)));
typedef unsigned u32x2 __attribute__((ext_vector_type(2)));
typedef unsigned u32x4 __attribute__((ext_vector_type(4)));

constexpr int T_ = 32768, S_ = 4096, NB_ = 8, DM = 1024, FF = 2816, NCOL = 7820, LDP = 3840;
constexpr float LOG2E = 1.4426950408889634f;
constexpr int C_NSAQ = 0, C_KCMP = 256, C_VCMP = 320, C_KSLC = 384, C_VSLC = 448, C_KWIN = 512, C_VWIN = 576, C_NGATE = 640;
constexpr int C_RETQ = 704, C_RETK = 960, C_RETV = 1216, C_RETG = 1728, C_RWKV = 2240, C_SWAQ = 3264, C_SWAK = 3520, C_SWAV = 3648;

enum { I_X = 0, I_F1PRE, I_F1POST, I_F1G, I_F1U, I_F1D, I_MPRE, I_MPOST, I_WIN, I_POSK, I_POSV, I_CKW1, I_CKW2, I_CVW1, I_CVW2, I_GNG,
       I_MU, I_W0, I_W2, I_A0, I_A2, I_G2, I_KK, I_KA, I_RK, I_LNG, I_LNB, I_SINK, I_PNSA, I_PRET, I_PRWKV, I_PSWA, I_WOUT,
       I_F2PRE, I_F2POST, I_F2G, I_F2U, I_F2D, N_IN };

constexpr size_t MiB = 1048576;
constexpr size_t WS_W = 0, WS_H = 56 * MiB, WS_R1 = 120 * MiB, WS_Y = 360 * MiB, WS_Z3 = 440 * MiB, WS_MISC = 504 * MiB, WS_END = 510 * MiB;
constexpr size_t W_GU1 = 0, W_D1 = W_GU1 + (size_t)5632 * 1024, W_IN = W_D1 + (size_t)1024 * 2816, W_GATE = W_IN + (size_t)3840 * 1024,
                 W_PNSA = W_GATE + (size_t)4096 * 1024, W_PRET = W_PNSA + 262144, W_PRWKV = W_PRET + 524288, W_PSWA = W_PRWKV + 262144,
                 W_OUT = W_PSWA + 262144, W_GU2 = W_OUT + 1048576, W_D2 = W_GU2 + (size_t)5632 * 1024, W_CK1 = W_D2 + (size_t)1024 * 2816,
                 W_CV1 = W_CK1 + 524288, W_ENDE = W_CV1 + 524288;
static_assert(W_ENDE * 2 <= 56 * MiB, "weights");
constexpr size_t R1_F = (size_t)T_ * FF * 2;
constexpr size_t Y_NSA = 0, Y_RET = (size_t)T_ * 256 * 2, Y_RWKV = Y_RET + (size_t)T_ * 512 * 2, Y_SWA = Y_RWKV + (size_t)T_ * 256 * 2;
constexpr size_t M_KCIN = 0, M_VCIN = M_KCIN + ((size_t)T_ + 64) * 64 * 2, M_H1K = M_VCIN + ((size_t)T_ + 64) * 64 * 2, M_H1V = M_H1K + 2048 * 256 * 2,
                 M_KC = M_H1V + 2048 * 256 * 2, M_VC = M_KC + 2048 * 64 * 2, M_SEL = M_VC + 2048 * 64 * 2, M_KV = M_SEL + (size_t)T_ * 8,
                 M_END = M_KV + (size_t)1024 * 8192 * 4;
static_assert(M_END <= 64 * MiB, "mixer scratch");
constexpr size_t X_ROPE = 0, X_CB = X_ROPE + (size_t)S_ * 32 * 8, X_CTR = X_CB + 4096;

struct Params { const float* in[N_IN]; float* out; unsigned char* ws; };

__device__ __forceinline__ unsigned cvt_pk_bf16(float lo, float hi) { unsigned r; asm("v_cvt_pk_bf16_f32 %0, %1, %2" : "=v"(r) : "v"(lo), "v"(hi)); return r; }
__device__ __forceinline__ float bf_lo(unsigned u) { return __uint_as_float(u << 16); }
__device__ __forceinline__ float bf_hi(unsigned u) { return __uint_as_float(u & 0xffff0000u); }
__device__ __forceinline__ float bf2f(bf16_t b) { return __uint_as_float(((unsigned)b) << 16); }
__device__ __forceinline__ float fast_exp2(float x) { return __builtin_amdgcn_exp2f(x); }
__device__ __forceinline__ float sigmoidf_(float x) { return 1.0f / (1.0f + __expf(-x)); }
__device__ __forceinline__ float wave_sum(float v) {
#pragma unroll
    for (int o = 1; o < 64; o <<= 1) v += __shfl_xor(v, o);
    return v;
}
__device__ __forceinline__ int opaque_tid() { int t = threadIdx.x; asm volatile("" : "+v"(t)); return t; }
__device__ __forceinline__ unsigned char* opq_ptr(unsigned char* p) { asm volatile("" : "+s"(p)); return p; }
__device__ __forceinline__ f32x16 mfma32(bf16x8 a, bf16x8 b, f32x16 c) { return __builtin_amdgcn_mfma_f32_32x32x16_bf16(a, b, c, 0, 0, 0); }
__device__ __forceinline__ f32x16 zero16() { f32x16 z;
#pragma unroll
    for (int i = 0; i < 16; ++i) z[i] = 0.f;
    return z; }

namespace pg8 {
constexpr int BM = 256, BK = 64, HALF = 128, HTB = HALF * BK * 2, STAGE_BYTES = 8 * HTB, NXCD = 8, WGM = 8;
__device__ __forceinline__ int lds_byte(int r, int c) { const int st = (r >> 4) * 2 + (c >> 5), rr = r & 15, cc = c & 31, ob = rr * 64 + cc * 2; return st * 1024 + (ob ^ (((ob >> 9) & 1) << 5)); }
__device__ __forceinline__ void stage_rc(int b, int& R, int& C) { const int st = b / 1024, sb = b % 1024, swz = sb ^ (((sb >> 9) & 1) << 5); R = (st >> 1) * 16 + swz / 64; C = (st & 1) * 32 + (swz % 64) / 2; }
struct Unit { int pm, pn; };
struct Gemm { const bf16_t* A; const bf16_t* Bt; int M, N, K, lda; };
struct StaticOrder {
    int nM, nN, nwg, G, c;
    __device__ void init(int M, int N, int G_, int c_) { nM = M / BM; nN = N / BM; nwg = nM * nN; G = G_; c = c_; }
    __device__ bool next(int i, Unit& u) const {
        const long L = (long)i * G + c; if (c < 0 || L >= nwg) return false;
        int wgid = (int)L; { const int q = nwg / NXCD, r = nwg % NXCD, xcd = wgid % NXCD, off = wgid / NXCD; wgid = (xcd < r ? xcd * (q + 1) : r * (q + 1) + (xcd - r) * q) + off; }
        const int nig = WGM * nN, gid = wgid / nig, fm = gid * WGM, gsz = (nM - fm) < WGM ? (nM - fm) : WGM;
        u.pm = fm + ((wgid % nig) % gsz); u.pn = (wgid % nig) / gsz; return true;
    }
};
template <class Epi, class Sched>
__device__ __forceinline__ void gemm_phase(LAS unsigned char* lds, const Gemm g, const Sched& S, const Epi& E) {
    const int tid = opaque_tid(), wid = __builtin_amdgcn_readfirstlane(tid >> 6), lane = tid & 63, wr = wid >> 2, wc = wid & 3, fr = lane & 15, fq = lane >> 4;
    const int K = g.K, nt = K / BK, lda = g.lda;
    unsigned voffA[2], voffB[2];
#pragma unroll
    for (int i = 0; i < 2; ++i) { int R, C; stage_rc(tid * 16 + i * 8192, R, C); voffA[i] = (unsigned)(R * lda + C) * 2u; voffB[i] = (unsigned)(R * K + C) * 2u; }
    const size_t kstep = (size_t)(BK * 2);
    const size_t hstepA = (size_t)HALF * lda * 2, hstepB = (size_t)HALF * K * 2;
    const size_t tstepA = 2 * hstepA, tstepB = 2 * hstepB;
    const unsigned ldsw = (unsigned)wid * 1024u;
    const int aoff = lds_byte(wr * 64 + fr, fq * 8), boff = lds_byte(wc * 32 + fr, fq * 8);
#define PG8_SA(b, h) (((b) * 2 + (h)) * HTB)
#define PG8_SB(b, h) ((4 + (b) * 2 + (h)) * HTB)
#define PG8_STAGE(bufoff, gbase, voff) do { _Pragma("unroll") for (int _i = 0; _i < 2; ++_i) \
        __builtin_amdgcn_global_load_lds((const unsigned*)((const char*)(gbase) + (voff)[_i]), (LAS unsigned*)(lds + (bufoff) + ldsw + _i * 8192), 16, 0, 0); } while (0)
#define PG8_LDA(dst, b, h) do { _Pragma("unroll") for (int m = 0; m < 4; ++m) _Pragma("unroll") for (int k = 0; k < 2; ++k) dst[m][k] = *(const LAS bf16x8*)(lds + PG8_SA(b, h) + aoff + m * 2048 + k * 1024); } while (0)
#define PG8_LDB(dst, b, h) do { _Pragma("unroll") for (int n = 0; n < 2; ++n) _Pragma("unroll") for (int k = 0; k < 2; ++k) dst[n][k] = *(const LAS bf16x8*)(lds + PG8_SB(b, h) + boff + n * 2048 + k * 1024); } while (0)
#define PG8_MMA(ai, bj, At, Bt) do { __builtin_amdgcn_s_setprio(1); _Pragma("unroll") for (int m = 0; m < 4; ++m) _Pragma("unroll") for (int n = 0; n < 2; ++n) _Pragma("unroll") for (int k = 0; k < 2; ++k) \
        acc[ai][bj][m][n] = __builtin_amdgcn_mfma_f32_16x16x32_bf16(Bt[n][k], At[m][k], acc[ai][bj][m][n], 0, 0, 0); __builtin_amdgcn_s_setprio(0); } while (0)
#define PG8_WAIT_V(n) asm volatile("s_waitcnt vmcnt(" #n ")" ::: "memory")
#define PG8_WAIT_L(n) asm volatile("s_waitcnt lgkmcnt(" #n ")" ::: "memory")
#define PG8_BAR __builtin_amdgcn_s_barrier()
#define PG8_SCHED __builtin_amdgcn_sched_barrier(0)
    Unit cur, nxt; int ui = 0;
    if (!S.next(0, cur)) return;
    f32x4 acc[2][2][4][2];
#pragma unroll
    for (int a = 0; a < 2; ++a)
#pragma unroll
        for (int b = 0; b < 2; ++b)
#pragma unroll
            for (int m = 0; m < 4; ++m)
#pragma unroll
                for (int n = 0; n < 2; ++n) acc[a][b][m][n] = (f32x4){0.f, 0.f, 0.f, 0.f};
    bf16x8 At[4][2], B0[2][2], B1[2][2];
    const char* cA = (const char*)g.A + (size_t)cur.pm * tstepA; const char* cB = (const char*)g.Bt + (size_t)cur.pn * tstepB;
    PG8_STAGE(PG8_SB(0, 0), cB, voffB); PG8_STAGE(PG8_SA(0, 0), cA, voffA); PG8_STAGE(PG8_SB(0, 1), cB + hstepB, voffB); PG8_STAGE(PG8_SA(0, 1), cA + hstepA, voffA);
    if (wr == 1) PG8_BAR;
    PG8_WAIT_V(4); PG8_BAR;
    PG8_STAGE(PG8_SB(1, 0), cB + kstep, voffB); PG8_STAGE(PG8_SA(1, 0), cA + kstep, voffA); PG8_STAGE(PG8_SB(1, 1), cB + hstepB + kstep, voffB);
    PG8_WAIT_V(6); PG8_BAR;
    for (;;) {
        const bool has_next = S.next(ui + 1, nxt);
        const char* nA = has_next ? (const char*)g.A + (size_t)nxt.pm * tstepA : cA; const char* nB = has_next ? (const char*)g.Bt + (size_t)nxt.pn * tstepB : cB;
        for (int t = 0; t < nt; t += 2) {
            const bool last = (t == nt - 2);
            const char* a1 = cA + (size_t)(t + 1) * kstep;
            const char* a2 = last ? nA : cA + (size_t)(t + 2) * kstep; const char* b2 = last ? nB : cB + (size_t)(t + 2) * kstep;
            const char* a3 = a2 + kstep; const char* b3 = b2 + kstep;
            PG8_LDB(B0, 0, 0); PG8_SCHED; PG8_LDA(At, 0, 0); PG8_STAGE(PG8_SA(1, 1), a1 + hstepA, voffA);
            PG8_WAIT_L(8); PG8_BAR; PG8_WAIT_L(0); PG8_MMA(0, 0, At, B0); PG8_BAR; PG8_SCHED;
            PG8_LDB(B1, 0, 1); PG8_STAGE(PG8_SB(0, 0), b2, voffB);
            PG8_BAR; PG8_WAIT_L(0); PG8_MMA(0, 1, At, B1); PG8_BAR;
            PG8_LDA(At, 0, 1); PG8_STAGE(PG8_SA(0, 0), a2, voffA);
            PG8_BAR; PG8_WAIT_L(0); PG8_MMA(1, 0, At, B0); PG8_BAR; PG8_SCHED;
            PG8_STAGE(PG8_SB(0, 1), b2 + hstepB, voffB);
            PG8_WAIT_V(6); PG8_BAR; PG8_MMA(1, 1, At, B1); PG8_BAR;
            PG8_LDB(B0, 1, 0); PG8_SCHED; PG8_LDA(At, 1, 0); PG8_STAGE(PG8_SA(0, 1), a2 + hstepA, voffA);
            PG8_WAIT_L(8); PG8_BAR; PG8_WAIT_L(0); PG8_MMA(0, 0, At, B0); PG8_BAR; PG8_SCHED;
            PG8_LDB(B1, 1, 1); PG8_STAGE(PG8_SB(1, 0), b3, voffB);
            PG8_BAR; PG8_WAIT_L(0); PG8_MMA(0, 1, At, B1); PG8_BAR;
            PG8_LDA(At, 1, 1); PG8_STAGE(PG8_SA(1, 0), a3, voffA);
            PG8_BAR; PG8_WAIT_L(0); PG8_MMA(1, 0, At, B0); PG8_BAR; PG8_SCHED;
            PG8_STAGE(PG8_SB(1, 1), b3 + hstepB, voffB);
            PG8_WAIT_V(6); PG8_BAR; PG8_MMA(1, 1, At, B1); PG8_BAR;
        }
        E(acc, cur, wr, wc, fr, fq);
        if (!has_next) break;
#pragma unroll
        for (int a = 0; a < 2; ++a)
#pragma unroll
            for (int b = 0; b < 2; ++b)
#pragma unroll
                for (int m = 0; m < 4; ++m)
#pragma unroll
                    for (int n = 0; n < 2; ++n) acc[a][b][m][n] = (f32x4){0.f, 0.f, 0.f, 0.f};
        cur = nxt; cA = nA; cB = nB; ++ui;
    }
    PG8_WAIT_V(0);
    if (wr == 0) PG8_BAR;
    PG8_BAR;
#undef PG8_SA
#undef PG8_SB
#undef PG8_STAGE
#undef PG8_LDA
#undef PG8_LDB
#undef PG8_MMA
#undef PG8_WAIT_V
#undef PG8_WAIT_L
#undef PG8_BAR
#undef PG8_SCHED
}
}
using pg8::Unit;
typedef f32x4 AccT[2][2][4][2];

struct EpiPlain {
    bf16_t* O; int ldc;
    __device__ __forceinline__ void operator()(const AccT& acc, const Unit& u, int wr, int wc, int fr, int fq) const {
        const int row0 = u.pm * 256 + wr * 64 + fr, col0 = u.pn * 256 + wc * 32 + 4 * fq;
#pragma unroll
        for (int ai = 0; ai < 2; ++ai)
#pragma unroll
            for (int m = 0; m < 4; ++m) { bf16_t* rowp = O + (size_t)(row0 + ai * 128 + m * 16) * ldc + col0;
#pragma unroll
                for (int bj = 0; bj < 2; ++bj)
#pragma unroll
                    for (int n = 0; n < 2; ++n) { const f32x4 v = acc[ai][bj][m][n]; *(u32x2*)(rowp + bj * 128 + n * 16) = (u32x2){cvt_pk_bf16(v[0], v[1]), cvt_pk_bf16(v[2], v[3])}; } }
    }
};
struct EpiSwiGLU {
    bf16_t* O;
    __device__ __forceinline__ void operator()(const AccT& acc, const Unit& u, int wr, int wc, int fr, int fq) const {
        const int row0 = u.pm * 256 + wr * 64 + fr, col0 = u.pn * 128 + wc * 32 + 4 * fq;
#pragma unroll
        for (int ai = 0; ai < 2; ++ai)
#pragma unroll
            for (int m = 0; m < 4; ++m) { bf16_t* rowp = O + (size_t)(row0 + ai * 128 + m * 16) * FF + col0;
#pragma unroll
                for (int n = 0; n < 2; ++n) { const f32x4 g = acc[ai][0][m][n], up = acc[ai][1][m][n]; float r[4];
#pragma unroll
                    for (int i = 0; i < 4; ++i) r[i] = g[i] * up[i] / (1.0f + __expf(-g[i]));
                    *(u32x2*)(rowp + n * 16) = (u32x2){cvt_pk_bf16(r[0], r[1]), cvt_pk_bf16(r[2], r[3])}; } }
    }
};
struct EpiGelu {
    bf16_t* O; const float* bias;
    __device__ __forceinline__ void operator()(const AccT& acc, const Unit& u, int wr, int wc, int fr, int fq) const {
        const int row0 = u.pm * 256 + wr * 64 + fr, col0 = u.pn * 256 + wc * 32 + 4 * fq;
#pragma unroll
        for (int ai = 0; ai < 2; ++ai)
#pragma unroll
            for (int m = 0; m < 4; ++m) { bf16_t* rowp = O + (size_t)(row0 + ai * 128 + m * 16) * 256 + col0;
#pragma unroll
                for (int bj = 0; bj < 2; ++bj)
#pragma unroll
                    for (int n = 0; n < 2; ++n) { const f32x4 v = acc[ai][bj][m][n]; const f32x4 b = *(const f32x4*)(bias + col0 + bj * 128 + n * 16); float r[4];
#pragma unroll
                        for (int i = 0; i < 4; ++i) { const float x = v[i] + b[i]; const float u2 = 1.5957691216057308f * (x + 0.044715f * x * x * x); r[i] = x / (1.0f + __expf(-u2)); }
                        *(u32x2*)(rowp + bj * 128 + n * 16) = (u32x2){cvt_pk_bf16(r[0], r[1]), cvt_pk_bf16(r[2], r[3])}; } }
    }
};
struct EpiWin {
    bf16_t* P; bf16_t* kcin; bf16_t* vcin; const f32x2* rope;
    __device__ __forceinline__ static bool roped(int hb) { return hb == C_KSLC || hb == C_KWIN || (hb >= C_RETK && hb < C_RETV) || (hb >= C_SWAK && hb < C_SWAV); }
    __device__ __forceinline__ void operator()(const AccT& acc, const Unit& u, int wr, int wc, int fr, int fq) const {
        const int row0 = u.pm * 256 + wr * 64 + fr;
#pragma unroll
        for (int bj = 0; bj < 2; ++bj) {
            const int base = u.pn * 256 + bj * 128 + wc * 32;
            const int hb = base & ~63;
            if (roped(hb)) {
                const int d1 = 16 * (wc & 1) + 4 * fq;
#pragma unroll
                for (int ai = 0; ai < 2; ++ai)
#pragma unroll
                    for (int m = 0; m < 4; ++m) { const int row = row0 + ai * 128 + m * 16; const f32x2* cs = rope + (size_t)(row & (S_ - 1)) * 32 + d1;
                        const f32x4 c01 = *(const f32x4*)cs, c23 = *(const f32x4*)(cs + 2);
                        const f32x4 a = acc[ai][bj][m][0], b = acc[ai][bj][m][1];
                        const float co[4] = {c01[0], c01[2], c23[0], c23[2]}, si[4] = {c01[1], c01[3], c23[1], c23[3]}; float o1[4], o2[4];
#pragma unroll
                        for (int i = 0; i < 4; ++i) { o1[i] = a[i] * co[i] - b[i] * si[i]; o2[i] = b[i] * co[i] + a[i] * si[i]; }
                        bf16_t* rp = P + (size_t)row * LDP + hb + d1;
                        *(u32x2*)rp = (u32x2){cvt_pk_bf16(o1[0], o1[1]), cvt_pk_bf16(o1[2], o1[3])};
                        *(u32x2*)(rp + 32) = (u32x2){cvt_pk_bf16(o2[0], o2[1]), cvt_pk_bf16(o2[2], o2[3])}; }
            } else {
#pragma unroll
                for (int ai = 0; ai < 2; ++ai)
#pragma unroll
                    for (int m = 0; m < 4; ++m) { const int row = row0 + ai * 128 + m * 16;
#pragma unroll
                        for (int n = 0; n < 2; ++n) { const int col = base + n * 16 + 4 * fq; const f32x4 v = acc[ai][bj][m][n];
                            const u32x2 w = (u32x2){cvt_pk_bf16(v[0], v[1]), cvt_pk_bf16(v[2], v[3])};
                            *(u32x2*)(P + (size_t)row * LDP + col) = w;
                            if (hb == C_KCMP) *(u32x2*)(kcin + (size_t)row * 64 + (col - C_KCMP)) = w;
                            if (hb == C_VCMP) *(u32x2*)(vcin + (size_t)row * 64 + (col - C_VCMP)) = w; } }
            }
        }
    }
};
struct EpiMerge {
    const bf16_t* Z[4]; bf16_t* O;
    __device__ __forceinline__ void operator()(const AccT& acc, const Unit& u, int wr, int wc, int fr, int fq) const {
        const int row0 = u.pm * 256 + wr * 64 + fr, col = u.pn * 64 + wc * 16 + 4 * fq;
#pragma unroll
        for (int ai = 0; ai < 2; ++ai)
#pragma unroll
            for (int m = 0; m < 4; ++m) { const size_t off = (size_t)(row0 + ai * 128 + m * 16) * DM + col; float r[4] = {0.f, 0.f, 0.f, 0.f};
#pragma unroll
                for (int br = 0; br < 4; ++br) { const f32x4 g = acc[ai][br >> 1][m][br & 1]; const u32x2 z = *(const u32x2*)(Z[br] + off);
                    r[0] += sigmoidf_(g[0]) * bf_lo(z[0]); r[1] += sigmoidf_(g[1]) * bf_hi(z[0]); r[2] += sigmoidf_(g[2]) * bf_lo(z[1]); r[3] += sigmoidf_(g[3]) * bf_hi(z[1]); }
                *(u32x2*)(O + off) = (u32x2){cvt_pk_bf16(r[0], r[1]), cvt_pk_bf16(r[2], r[3])}; }
    }
};

template <class Epi>
__device__ __forceinline__ void run_gemm(LAS unsigned char* lds, const bf16_t* A, int lda, const bf16_t* Bt, int M, int N, int K, const Epi& E, int G, int c) {
    pg8::Gemm g; g.A = A; g.Bt = Bt; g.M = M; g.N = N; g.K = K; g.lda = lda;
    pg8::StaticOrder S; S.init(M, N, G, c);
    pg8::gemm_phase<Epi, pg8::StaticOrder>(lds, g, S, E);
}

struct MapId { const float* src; int ld; __device__ const float* ptr(int n) const { return src + n; } };
struct MapGU { const float* g; const float* u; int ld; __device__ const float* ptr(int n) const { const int j = n >> 8, w = n & 255; return (w < 128) ? g + 128 * j + w : u + 128 * j + (w - 128); } };
__device__ __forceinline__ int swap45(int x) { return (x & ~48) | ((x & 16) << 1) | ((x & 32) >> 1); }
struct MapWin { const float* src; int ld;
    __device__ const float* ptr(int n) const {
        if (n >= 3776 || (n >= 652 && n < 704)) return nullptr;
        const int hb = n & ~63; int c = n;
        if (EpiWin::roped(hb)) c = hb + swap45(n - hb);
        return src + (c < 652 ? c : c - 52); } };
struct MapGate { const float* src; int ld;
    __device__ const float* ptr(int n) const { const int pn = n >> 8, rho = n & 255, bj = rho >> 7, wc = (rho >> 5) & 3, nn = (rho >> 4) & 1, q = rho & 15;
        return src + 3724 + (2 * bj + nn) * 1024 + 64 * pn + 16 * wc + q; } };

template <class Map>
__device__ __forceinline__ void conv_tiles(const Map mp, int K, int N, bf16_t* dst, LAS float* tile, int& item_base, int bid, int nb) {
    const int nn = N / 64, total = (K / 64) * nn, tid = opaque_tid();
    int first = (bid - (item_base % nb) + nb) % nb;
    for (int it = first; it < total; it += nb) {
        const int k0 = (it / nn) * 64, n0 = (it % nn) * 64;
        { const int ty = tid >> 6, tx = tid & 63; const float* sp = mp.ptr(n0 + tx);
#pragma unroll
          for (int kk = ty; kk < 64; kk += 8) tile[kk * 65 + tx] = sp ? sp[(size_t)(k0 + kk) * mp.ld] : 0.f; }
        __syncthreads();
        { const int n = tid >> 3, kc = tid & 7; const LAS float* s = tile + (8 * kc) * 65 + n;
          u32x4 o; o.x = cvt_pk_bf16(s[0], s[65]); o.y = cvt_pk_bf16(s[2 * 65], s[3 * 65]); o.z = cvt_pk_bf16(s[4 * 65], s[5 * 65]); o.w = cvt_pk_bf16(s[6 * 65], s[7 * 65]);
          *(u32x4*)(dst + (size_t)(n0 + n) * K + k0 + 8 * kc) = o; }
        __syncthreads();
    }
    item_base += total;
}

__device__ __forceinline__ void phase_convert(const Params& P, int l, LAS unsigned char* lds, int bid, int nb) {
    const int ctid = opaque_tid(); bf16_t* W = (bf16_t*)(P.ws + WS_W); LAS float* tile = (LAS float*)lds; int ib = 0;
    conv_tiles(MapGU{P.in[I_F1G] + (size_t)l * DM * FF, P.in[I_F1U] + (size_t)l * DM * FF, FF}, DM, 5632, W + W_GU1, tile, ib, bid, nb);
    conv_tiles(MapId{P.in[I_F1D] + (size_t)l * FF * DM, DM}, FF, DM, W + W_D1, tile, ib, bid, nb);
    conv_tiles(MapWin{P.in[I_WIN] + (size_t)l * DM * NCOL, NCOL}, DM, LDP, W + W_IN, tile, ib, bid, nb);
    conv_tiles(MapGate{P.in[I_WIN] + (size_t)l * DM * NCOL, NCOL}, DM, 4096, W + W_GATE, tile, ib, bid, nb);
    conv_tiles(MapId{P.in[I_PNSA] + (size_t)l * 256 * DM, DM}, 256, DM, W + W_PNSA, tile, ib, bid, nb);
    conv_tiles(MapId{P.in[I_PRET] + (size_t)l * 512 * DM, DM}, 512, DM, W + W_PRET, tile, ib, bid, nb);
    conv_tiles(MapId{P.in[I_PRWKV] + (size_t)l * 256 * DM, DM}, 256, DM, W + W_PRWKV, tile, ib, bid, nb);
    conv_tiles(MapId{P.in[I_PSWA] + (size_t)l * 256 * DM, DM}, 256, DM, W + W_PSWA, tile, ib, bid, nb);
    conv_tiles(MapId{P.in[I_WOUT] + (size_t)l * DM * DM, DM}, DM, DM, W + W_OUT, tile, ib, bid, nb);
    conv_tiles(MapGU{P.in[I_F2G] + (size_t)l * DM * FF, P.in[I_F2U] + (size_t)l * DM * FF, FF}, DM, 5632, W + W_GU2, tile, ib, bid, nb);
    conv_tiles(MapId{P.in[I_F2D] + (size_t)l * FF * DM, DM}, FF, DM, W + W_D2, tile, ib, bid, nb);
    conv_tiles(MapId{P.in[I_CKW1] + (size_t)l * 2048 * 256, 256}, 2048, 256, W + W_CK1, tile, ib, bid, nb);
    conv_tiles(MapId{P.in[I_CVW1] + (size_t)l * 2048 * 256, 256}, 2048, 256, W + W_CV1, tile, ib, bid, nb);
    if (bid >= nb - 2 && ctid < 256) {
        const int kv = nb - 1 - bid, j = ctid;
        const float* pos = P.in[kv ? I_POSV : I_POSK] + (size_t)l * 2048; const float* w1 = P.in[kv ? I_CVW1 : I_CKW1] + (size_t)l * 2048 * 256;
        float s = 0.f; for (int i = 0; i < 2048; ++i) s += pos[i] * w1[(size_t)i * 256 + j];
        ((float*)(P.ws + WS_MISC + X_CB))[kv * 256 + j] = s;
    }
    if (l == 0) {
        f32x2* rope = (f32x2*)(P.ws + WS_MISC + X_ROPE);
        for (int e = bid * 512 + ctid; e < S_ * 32; e += nb * 512) {
            const int pos = e >> 5, i = e & 31; const float invf = powf(10000.0f, -(float)i * 2.0f / 64.0f); const float ang = (float)pos * invf;
            double a = (double)ang; const double k = rint(a * 0.15915494309189535); a -= k * 6.283185307179586;
            const float af = (float)a; rope[e] = (f32x2){cosf(af), sinf(af)}; }
        bf16_t* kc = (bf16_t*)(P.ws + WS_Z3 + M_KCIN); bf16_t* vc = (bf16_t*)(P.ws + WS_Z3 + M_VCIN);
        for (int e = bid * 512 + ctid; e < 64 * 64; e += nb * 512) { kc[(size_t)T_ * 64 + e] = 0; vc[(size_t)T_ * 64 + e] = 0; }
    }
}

__device__ __forceinline__ void phase_rowpass(const float* xin, const bf16_t* F, const float* gpost, float coef, float* xout, const float* gpre, bf16_t* h, int bid, int nb) {
    const int tid_ = opaque_tid(), lane = tid_ & 63, gw = bid * 8 + (tid_ >> 6), NGW = nb * 8;
    for (int row = gw; row < T_; row += NGW) {
        const f32x4* xr = (const f32x4*)(xin + (size_t)row * DM) + lane; f32x4 x[4];
#pragma unroll
        for (int j = 0; j < 4; ++j) x[j] = xr[64 * j];
        if (F) {
            const u32x2* fr = (const u32x2*)(F + (size_t)row * DM) + lane; f32x4 f[4]; float s = 0.f;
#pragma unroll
            for (int j = 0; j < 4; ++j) { const u32x2 w = fr[64 * j]; f[j] = (f32x4){bf_lo(w[0]), bf_hi(w[0]), bf_lo(w[1]), bf_hi(w[1])}; s += (f[j][0] * f[j][0] + f[j][1] * f[j][1]) + (f[j][2] * f[j][2] + f[j][3] * f[j][3]); }
            const float rs = coef * rsqrtf(wave_sum(s) * (1.0f / DM) + 1e-6f);
#pragma unroll
            for (int j = 0; j < 4; ++j) { const f32x4 g = ((const f32x4*)gpost)[64 * j + lane]; x[j] = x[j] + f[j] * g * rs; }
        }
        f32x4* xo = (f32x4*)(xout + (size_t)row * DM) + lane;
#pragma unroll
        for (int j = 0; j < 4; ++j) xo[64 * j] = x[j];
        if (gpre) {
            float s = 0.f;
#pragma unroll
            for (int j = 0; j < 4; ++j) s += (x[j][0] * x[j][0] + x[j][1] * x[j][1]) + (x[j][2] * x[j][2] + x[j][3] * x[j][3]);
            const float rs = rsqrtf(wave_sum(s) * (1.0f / DM) + 1e-6f);
            u32x2* ho = (u32x2*)(h + (size_t)row * DM) + lane;
#pragma unroll
            for (int j = 0; j < 4; ++j) { const f32x4 g = ((const f32x4*)gpre)[64 * j + lane]; const f32x4 v = x[j] * g * rs; ho[64 * j] = (u32x2){cvt_pk_bf16(v[0], v[1]), cvt_pk_bf16(v[2], v[3])}; }
        }
    }
}

constexpr int A_KS = 0, A_VTS = 9216, A_MISC = 32768;
struct QF { bf16x8 f[4]; };
__device__ __forceinline__ bf16x8 pack8(const float* v) { u32x4 w = (u32x4){cvt_pk_bf16(v[0], v[1]), cvt_pk_bf16(v[2], v[3]), cvt_pk_bf16(v[4], v[5]), cvt_pk_bf16(v[6], v[7])}; return __builtin_bit_cast(bf16x8, w); }
__device__ __forceinline__ void load_q(QF& q, const bf16_t* qrow, int h, const f32x2* ropeRow, float scale) {
    float v[4][8];
#pragma unroll
    for (int ks = 0; ks < 4; ++ks) { const u32x4 w = *(const u32x4*)(qrow + 16 * ks + 8 * h);
        v[ks][0] = bf_lo(w.x); v[ks][1] = bf_hi(w.x); v[ks][2] = bf_lo(w.y); v[ks][3] = bf_hi(w.y); v[ks][4] = bf_lo(w.z); v[ks][5] = bf_hi(w.z); v[ks][6] = bf_lo(w.w); v[ks][7] = bf_hi(w.w); }
    if (ropeRow) {
#pragma unroll
        for (int ks = 0; ks < 2; ++ks)
#pragma unroll
            for (int j = 0; j < 8; ++j) { const f32x2 cs = ropeRow[16 * ks + 8 * h + j]; const float a = v[ks][j], b = v[ks + 2][j]; v[ks][j] = a * cs.x - b * cs.y; v[ks + 2][j] = b * cs.x + a * cs.y; }
    }
#pragma unroll
    for (int ks = 0; ks < 4; ++ks) {
#pragma unroll
        for (int j = 0; j < 8; ++j) v[ks][j] *= scale;
        q.f[ks] = pack8(v[ks]); }
}
__device__ __forceinline__ void qk_tile(const LAS unsigned char* Ks, const QF& q, int r, int h, f32x16 (&s)[2]) {
#pragma unroll
    for (int kt = 0; kt < 2; ++kt) { s[kt] = zero16();
#pragma unroll
        for (int ks = 0; ks < 4; ++ks) { const bf16x8 a = *(const LAS bf16x8*)(Ks + ((32 * kt + r) * 72 + 16 * ks + 8 * h) * 2); s[kt] = mfma32(a, q.f[ks], s[kt]); } }
}
__device__ __forceinline__ void pv_tile(const LAS unsigned char* Vts, int vrow0, const f32x16 (&p)[2], int r, int h, f32x16 (&o)[2]) {
#pragma unroll
    for (int kt = 0; kt < 2; ++kt)
#pragma unroll
        for (int s2 = 0; s2 < 2; ++s2) { float t[8];
#pragma unroll
            for (int j = 0; j < 8; ++j) t[j] = p[kt][8 * s2 + j];
            const bf16x8 pf = pack8(t);
#pragma unroll
            for (int dt = 0; dt < 2; ++dt) { const LAS unsigned char* ap = Vts + ((vrow0 + 32 * dt + r) * 68 + 32 * kt + 16 * s2 + 4 * h) * 2;
                const u32x2 lo = *(const LAS u32x2*)ap, hi = *(const LAS u32x2*)(ap + 16);
                const bf16x8 a = __builtin_bit_cast(bf16x8, (u32x4){lo.x, lo.y, hi.x, hi.y}); o[dt] = mfma32(a, pf, o[dt]); } }
}
__device__ __forceinline__ void softmax_update(f32x16 (&s)[2], int lo, int hi, int h, float& m, float& l, f32x16 (&o)[2]) {
    float mx = m;
#pragma unroll
    for (int kt = 0; kt < 2; ++kt)
#pragma unroll
        for (int reg = 0; reg < 16; ++reg) { const int kl = 32 * kt + (reg & 3) + 8 * (reg >> 2) + 4 * h; const bool v = (kl >= lo) && (kl <= hi);
            const float x = v ? s[kt][reg] : -INFINITY; s[kt][reg] = x; mx = fmaxf(mx, x); }
    mx = fmaxf(mx, __shfl_xor(mx, 32));
    const float alpha = fast_exp2(m - mx); m = mx; float ls = 0.f;
#pragma unroll
    for (int kt = 0; kt < 2; ++kt)
#pragma unroll
        for (int reg = 0; reg < 16; ++reg) { const float p = fast_exp2(s[kt][reg] - mx); s[kt][reg] = p; ls += p; }
    l = l * alpha + ls;
#pragma unroll
    for (int dt = 0; dt < 2; ++dt) o[dt] = o[dt] * alpha;
}
__device__ __forceinline__ void store_kv_tile(LAS unsigned char* shm, u32x4 kreg, u32x4 vreg, int key, int c) {
    *(LAS u32x4*)(shm + A_KS + key * 144 + c * 16) = kreg;
    LAS bf16_t* vt = (LAS bf16_t*)(shm + A_VTS) + (8 * c) * 68 + key;
    vt[0] = (bf16_t)(vreg.x & 0xffff); vt[68] = (bf16_t)(vreg.x >> 16); vt[136] = (bf16_t)(vreg.y & 0xffff); vt[204] = (bf16_t)(vreg.y >> 16);
    vt[272] = (bf16_t)(vreg.z & 0xffff); vt[340] = (bf16_t)(vreg.z >> 16); vt[408] = (bf16_t)(vreg.w & 0xffff); vt[476] = (bf16_t)(vreg.w >> 16);
}
template <int MODE, class TR, class MK>
__device__ __forceinline__ void flash_loop(int ntiles, TR tileRow, MK maskAt, const bf16_t* Kg, const bf16_t* Vg, int ld, const QF& q, float& m, float& l, f32x16 (&o)[2],
                                           LAS unsigned char* shm, int tid, int lane, float inv = 0.f, LAS float* imp = nullptr, int qloc = 0) {
    if (ntiles <= 0) return;
    const int key = tid >> 3, c = tid & 7, r = lane & 31, h = lane >> 5;
    u32x4 kreg, vreg;
    { const size_t off = (size_t)(tileRow(0) + key) * ld + 8 * c; kreg = *(const u32x4*)(Kg + off); vreg = *(const u32x4*)(Vg + off); }
    for (int i = 0; i < ntiles; ++i) {
        __syncthreads();
        store_kv_tile(shm, kreg, vreg, key, c);
        __syncthreads();
        if (i + 1 < ntiles) { const size_t off = (size_t)(tileRow(i + 1) + key) * ld + 8 * c; kreg = *(const u32x4*)(Kg + off); vreg = *(const u32x4*)(Vg + off); }
        int lo, hi; maskAt(i, lo, hi);
        f32x16 s[2]; qk_tile(shm + A_KS, q, r, h, s);
        if (MODE == 0) { softmax_update(s, lo, hi, h, m, l, o); pv_tile(shm + A_VTS, 0, s, r, h, o); }
        else if (MODE == 1) { f32x16 dummy[2]; dummy[0] = zero16(); dummy[1] = zero16(); softmax_update(s, lo, hi, h, m, l, dummy); }
        else {
#pragma unroll
            for (int kt = 0; kt < 2; ++kt)
#pragma unroll
                for (int g = 0; g < 4; ++g) { float sum4 = 0.f, p3 = 0.f;
#pragma unroll
                    for (int e = 0; e < 4; ++e) { const int reg = 4 * g + e, kl = 32 * kt + 8 * g + 4 * h + e; const bool v = (kl >= lo) && (kl <= hi);
                        const float p = v ? fast_exp2(s[kt][reg] - m) * inv : 0.f; s[kt][reg] = p; sum4 += p; p3 = p; }
                    const int j = 16 * i + 8 * kt + 2 * g + h;
                    __hip_atomic_fetch_add(imp + qloc * 65 + j, sum4, __ATOMIC_RELAXED, __HIP_MEMORY_SCOPE_WORKGROUP);
                    if (j + 1 < 64) __hip_atomic_fetch_add(imp + qloc * 65 + j + 1, p3, __ATOMIC_RELAXED, __HIP_MEMORY_SCOPE_WORKGROUP); }
            pv_tile(shm + A_VTS, 0, s, r, h, o);
        }
    }
}

__device__ __forceinline__ void swa_item(const Params& P, int l, int it, LAS unsigned char* shm) {
    const int tid = opaque_tid(), lane = tid & 63, w = tid >> 6, r = lane & 31, h = lane >> 5;
    const int b = it >> 6, kvh = (it >> 5) & 1, qt = it & 31;
    const bf16_t* p = (const bf16_t*)(P.ws + WS_R1) + (size_t)b * S_ * LDP; const f32x2* rope = (const f32x2*)(P.ws + WS_MISC + X_ROPE);
    const int g = w >> 2, qsub = w & 3, head = 2 * kvh + g, qpos = 128 * qt + 32 * qsub + r;
    QF q; load_q(q, p + (size_t)qpos * LDP + C_SWAQ + 64 * head, h, rope + (size_t)qpos * 32, 0.125f * LOG2E);
    float m = P.in[I_SINK][l * 4 + head] * LOG2E, lsum = (h == 0) ? 1.f : 0.f; f32x16 o[2]; o[0] = zero16(); o[1] = zero16();
    const int j0 = (qt == 0) ? 0 : 2 * qt - 2, nt = 2 * qt + 2 - j0;
    flash_loop<0>(nt, [&](int i) { return 64 * (j0 + i); }, [&](int i, int& lo, int& hi) { const int tb = 64 * (j0 + i); lo = qpos - 127 - tb; hi = qpos - tb; },
                  p + C_SWAK + 64 * kvh, p + C_SWAV + 64 * kvh, LDP, q, m, lsum, o, shm, tid, lane);
    lsum += __shfl_xor(lsum, 32); const float inv = 1.0f / lsum;
    bf16_t* y = (bf16_t*)(P.ws + WS_Y + Y_SWA) + ((size_t)b * S_ + qpos) * 256 + 64 * head;
#pragma unroll
    for (int dt = 0; dt < 2; ++dt)
#pragma unroll
        for (int gg = 0; gg < 4; ++gg) { const f32x16& a = o[dt]; *(u32x2*)(y + 32 * dt + 8 * gg + 4 * h) = (u32x2){cvt_pk_bf16(a[4 * gg] * inv, a[4 * gg + 1] * inv), cvt_pk_bf16(a[4 * gg + 2] * inv, a[4 * gg + 3] * inv)}; }
}

__device__ __forceinline__ void nsa_cmp_item(const Params& P, int it, LAS unsigned char* shm) {
    const int tid = opaque_tid(), lane = tid & 63, w = tid >> 6, r = lane & 31, h = lane >> 5;
    const int b = it >> 6, qt = it & 63, q0 = 64 * qt;
    const bf16_t* p = (const bf16_t*)(P.ws + WS_R1) + (size_t)b * S_ * LDP;
    const bf16_t* kc = (const bf16_t*)(P.ws + WS_Z3 + M_KC) + (size_t)b * 256 * 64; const bf16_t* vc = (const bf16_t*)(P.ws + WS_Z3 + M_VC) + (size_t)b * 256 * 64;
    LAS float* imp = (LAS float*)(shm + A_MISC);
    for (int e = tid; e < 64 * 65; e += 512) imp[e] = 0.f;
    const int hd = w >> 1, qsub = w & 1, qloc = 32 * qsub + r, qpos = q0 + qloc;
    QF q; load_q(q, p + (size_t)qpos * LDP + C_NSAQ + 64 * hd, h, nullptr, 0.125f * LOG2E);
    const int nmax = (qpos - 31) >> 4, nml = (q0 + 63 - 31) >> 4, nt = nml < 0 ? 0 : (nml >> 6) + 1;
    float m = -1e30f, lsum = 0.f; f32x16 o[2]; o[0] = zero16(); o[1] = zero16();
    auto tr = [&](int i) { return 64 * i; }; auto mk = [&](int i, int& lo, int& hi) { lo = 0; hi = nmax - 64 * i; };
    flash_loop<1>(nt, tr, mk, kc, vc, 64, q, m, lsum, o, shm, tid, lane);
    lsum += __shfl_xor(lsum, 32); const float inv = lsum > 0.f ? 1.0f / lsum : 0.f;
    flash_loop<2>(nt, tr, mk, kc, vc, 64, q, m, lsum, o, shm, tid, lane, inv, imp, qloc);
    const float g0 = sigmoidf_(bf2f(p[(size_t)qpos * LDP + C_NGATE + hd * 3 + 0]));
    bf16_t* y = (bf16_t*)(P.ws + WS_Y + Y_NSA) + ((size_t)b * S_ + qpos) * 256 + 64 * hd;
#pragma unroll
    for (int dt = 0; dt < 2; ++dt)
#pragma unroll
        for (int gg = 0; gg < 4; ++gg) { const f32x16& a = o[dt]; *(u32x2*)(y + 32 * dt + 8 * gg + 4 * h) = (u32x2){cvt_pk_bf16(a[4 * gg] * g0, a[4 * gg + 1] * g0), cvt_pk_bf16(a[4 * gg + 2] * g0, a[4 * gg + 3] * g0)}; }
    __syncthreads();
    LAS float* scr = (LAS float*)(shm + A_MISC + 20480) + w * 64; unsigned long long* selm = (unsigned long long*)(P.ws + WS_Z3 + M_SEL) + (size_t)b * S_ + q0;
    const int cur = qt, j = lane;
    for (int qq = 8 * w; qq < 8 * w + 8; ++qq) {
        const bool forced = (j == 0) || (j == cur) || (j == cur - 1), valid = j <= cur;
        const float sc = forced ? 1e9f : (valid ? imp[qq * 65 + j] : -1e9f);
        scr[j] = sc; int rank = 0;
        for (int i = 0; i < 64; ++i) { const float si = scr[i]; rank += (si > sc || (si == sc && i < j)) ? 1 : 0; }
        const unsigned long long msk = __ballot(valid && rank < 16);
        if (lane == 0) selm[qq] = msk;
    }
    __syncthreads();
}

__device__ __forceinline__ void nsa_selwin_item(const Params& P, int it, LAS unsigned char* shm) {
    const int tid = opaque_tid(), lane = tid & 63, w = tid >> 6, r = lane & 31, h = lane >> 5;
    const int b = it >> 6, qt = it & 63, q0 = 64 * qt;
    const bf16_t* p = (const bf16_t*)(P.ws + WS_R1) + (size_t)b * S_ * LDP; const f32x2* rope = (const f32x2*)(P.ws + WS_MISC + X_ROPE);
    const unsigned long long* selm = (const unsigned long long*)(P.ws + WS_Z3 + M_SEL) + (size_t)b * S_ + q0;
    const int hd = w >> 1, qsub = w & 1, qloc = 32 * qsub + r, qpos = q0 + qloc;
    LAS int* list = (LAS int*)(shm + A_MISC);
    unsigned long long un = selm[lane];
#pragma unroll
    for (int off = 1; off < 64; off <<= 1) { const unsigned lo = __shfl_xor((unsigned)un, off), hi = __shfl_xor((unsigned)(un >> 32), off); un |= ((unsigned long long)hi << 32) | lo; }
    const int nsel = __popcll(un);
    __syncthreads();
    if (tid == 0) { unsigned long long u = un; int k = 0; while (u) { list[k++] = __ffsll((long long)u) - 1; u &= u - 1; } }
    __syncthreads();
    const unsigned long long mysel = selm[qloc];
    QF q; load_q(q, p + (size_t)qpos * LDP + C_NSAQ + 64 * hd, h, rope + (size_t)qpos * 32, 0.125f * LOG2E);
    float yacc[2][16];
    const float g1 = sigmoidf_(bf2f(p[(size_t)qpos * LDP + C_NGATE + hd * 3 + 1])), g2 = sigmoidf_(bf2f(p[(size_t)qpos * LDP + C_NGATE + hd * 3 + 2]));
    {
        float m = -1e30f, lsum = 0.f; f32x16 o[2]; o[0] = zero16(); o[1] = zero16();
        flash_loop<0>(nsel, [&](int i) { return 64 * list[i]; },
                      [&](int i, int& lo, int& hi) { const int j = list[i]; lo = 0; hi = ((mysel >> j) & 1ull) ? (qpos - 64 * j) : -1; },
                      p + C_KSLC, p + C_VSLC, LDP, q, m, lsum, o, shm, tid, lane);
        lsum += __shfl_xor(lsum, 32); const float inv = lsum > 0.f ? g1 / lsum : 0.f;
#pragma unroll
        for (int dt = 0; dt < 2; ++dt)
#pragma unroll
            for (int e = 0; e < 16; ++e) yacc[dt][e] = o[dt][e] * inv;
    }
    {
        float m = -1e30f, lsum = 0.f; f32x16 o[2]; o[0] = zero16(); o[1] = zero16();
        const int j0 = qt >= 8 ? qt - 8 : 0, nt = qt - j0 + 1;
        flash_loop<0>(nt, [&](int i) { return 64 * (j0 + i); }, [&](int i, int& lo, int& hi) { const int tb = 64 * (j0 + i); lo = qpos - 511 - tb; hi = qpos - tb; },
                      p + C_KWIN, p + C_VWIN, LDP, q, m, lsum, o, shm, tid, lane);
        lsum += __shfl_xor(lsum, 32); const float inv = g2 / lsum;
#pragma unroll
        for (int dt = 0; dt < 2; ++dt)
#pragma unroll
            for (int e = 0; e < 16; ++e) yacc[dt][e] += o[dt][e] * inv;
    }
    bf16_t* y = (bf16_t*)(P.ws + WS_Y + Y_NSA) + ((size_t)b * S_ + qpos) * 256 + 64 * hd;
#pragma unroll
    for (int dt = 0; dt < 2; ++dt)
#pragma unroll
        for (int gg = 0; gg < 4; ++gg) { u32x2* yp = (u32x2*)(y + 32 * dt + 8 * gg + 4 * h); const u32x2 c = *yp; const float* a = &yacc[dt][4 * gg];
            *yp = (u32x2){cvt_pk_bf16(a[0] + bf_lo(c.x), a[1] + bf_hi(c.x)), cvt_pk_bf16(a[2] + bf_lo(c.y), a[3] + bf_hi(c.y))}; }
    __syncthreads();
}

__device__ __forceinline__ float ret_log2g(int hd) { return log2f(1.0f - exp2f(-5.0f - (float)hd)); }
__device__ __forceinline__ void ret_kv_item(const Params& P, int it, LAS unsigned char* shm) {
    const int tid = opaque_tid(), lane = tid & 63, w = tid >> 6, r = lane & 31, h = lane >> 5;
    const int n = it & 31, hd = (it >> 5) & 3, b = it >> 7;
    const bf16_t* p = (const bf16_t*)(P.ws + WS_R1) + ((size_t)b * S_ + 128 * n) * LDP;
    LAS bf16_t* Kt = (LAS bf16_t*)shm; LAS bf16_t* Vt = (LAS bf16_t*)(shm + 17408);
    const float l2g = ret_log2g(hd);
    __syncthreads();
#pragma unroll
    for (int i = 0; i < 2; ++i) { const int task = tid + 512 * i, tok = task >> 3, c = task & 7; const u32x4 wv = *(const u32x4*)(p + (size_t)tok * LDP + C_RETK + 64 * hd + 8 * c);
        const float z = fast_exp2(l2g * (float)(127 - tok)); const unsigned ww[4] = {wv.x, wv.y, wv.z, wv.w}; LAS bf16_t* kt = Kt + (8 * c) * 136 + tok;
#pragma unroll
        for (int e = 0; e < 4; ++e) { const unsigned pk = cvt_pk_bf16(bf_lo(ww[e]) * z, bf_hi(ww[e]) * z); kt[(2 * e) * 136] = (bf16_t)(pk & 0xffff); kt[(2 * e + 1) * 136] = (bf16_t)(pk >> 16); } }
#pragma unroll
    for (int i = 0; i < 4; ++i) { const int task = tid + 512 * i, tok = task >> 4, c = task & 15; const u32x4 wv = *(const u32x4*)(p + (size_t)tok * LDP + C_RETV + 128 * hd + 8 * c);
        const unsigned ww[4] = {wv.x, wv.y, wv.z, wv.w}; LAS bf16_t* vt = Vt + (8 * c) * 136 + tok;
#pragma unroll
        for (int e = 0; e < 4; ++e) { vt[(2 * e) * 136] = (bf16_t)(ww[e] & 0xffff); vt[(2 * e + 1) * 136] = (bf16_t)(ww[e] >> 16); } }
    __syncthreads();
    const int et = w >> 1, dtile = w & 1; f32x16 acc = zero16();
#pragma unroll
    for (int s = 0; s < 8; ++s) { const bf16x8 a = *(const LAS bf16x8*)(Vt + (32 * et + r) * 136 + 16 * s + 8 * h), bb = *(const LAS bf16x8*)(Kt + (32 * dtile + r) * 136 + 16 * s + 8 * h); acc = mfma32(a, bb, acc); }
    float* kv = (float*)(P.ws + WS_Z3 + M_KV) + (size_t)it * 8192;
#pragma unroll
    for (int reg = 0; reg < 16; ++reg) { const int e = 32 * et + (reg & 3) + 8 * (reg >> 2) + 4 * h; kv[e * 64 + 32 * dtile + r] = acc[reg]; }
}

__device__ __forceinline__ void ret_out_item(const Params& P, int l, int it, LAS unsigned char* shm) {
    const int tid = opaque_tid(), lane = tid & 63, w = tid >> 6, r = lane & 31, h = lane >> 5;
    const int n = it & 31, hd = (it >> 5) & 3, b = it >> 7;
    const bf16_t* p = (const bf16_t*)(P.ws + WS_R1) + ((size_t)b * S_ + 128 * n) * LDP; const f32x2* rope = (const f32x2*)(P.ws + WS_MISC + X_ROPE);
    LAS bf16_t* Rt = (LAS bf16_t*)(shm + A_MISC); LAS f32x2* part = (LAS f32x2*)(shm + A_MISC + 18432);
    const float l2g = ret_log2g(hd), gch = fast_exp2(l2g * 128.0f);
    __syncthreads();
    {
        const float* kv = (const float*)(P.ws + WS_Z3 + M_KV) + (size_t)(it - n) * 8192 + tid * 16; f32x4 a[4];
#pragma unroll
        for (int i = 0; i < 4; ++i) a[i] = (f32x4){0.f, 0.f, 0.f, 0.f};
#pragma unroll 4
        for (int j = 0; j < n; ++j) { const f32x4* s = (const f32x4*)(kv + (size_t)j * 8192);
#pragma unroll
            for (int i = 0; i < 4; ++i) a[i] = a[i] * gch + s[i]; }
        const int e = tid >> 2, d0 = (tid & 3) * 16; LAS u32x4* dst = (LAS u32x4*)(Rt + e * 72 + d0);
        dst[0] = (u32x4){cvt_pk_bf16(a[0][0], a[0][1]), cvt_pk_bf16(a[0][2], a[0][3]), cvt_pk_bf16(a[1][0], a[1][1]), cvt_pk_bf16(a[1][2], a[1][3])};
        dst[1] = (u32x4){cvt_pk_bf16(a[2][0], a[2][1]), cvt_pk_bf16(a[2][2], a[2][3]), cvt_pk_bf16(a[3][0], a[3][1]), cvt_pk_bf16(a[3][2], a[3][3])};
    }
    const int qsub = w & 3, eh = w >> 2, qc = 32 * qsub + r, qpos = 128 * n + qc;
    QF q; load_q(q, p + (size_t)qc * LDP + C_RETQ + 64 * hd, h, rope + (size_t)qpos * 32, 0.125f);
    __syncthreads();
    f32x16 o[2];
#pragma unroll
    for (int dt = 0; dt < 2; ++dt) { o[dt] = zero16();
#pragma unroll
        for (int ks = 0; ks < 4; ++ks) { const bf16x8 a = *(const LAS bf16x8*)(Rt + (64 * eh + 32 * dt + r) * 72 + 16 * ks + 8 * h); o[dt] = mfma32(a, q.f[ks], o[dt]); }
        o[dt] = o[dt] * fast_exp2(l2g * (float)(qc + 1)); }
    const int key = tid >> 3, c = tid & 7;
    for (int kt2 = 0; kt2 < 2; ++kt2) {
        const size_t off = (size_t)(64 * kt2 + key) * LDP;
        const u32x4 kreg = *(const u32x4*)(p + off + C_RETK + 64 * hd + 8 * c), v0 = *(const u32x4*)(p + off + C_RETV + 128 * hd + 8 * c), v1 = *(const u32x4*)(p + off + C_RETV + 128 * hd + 64 + 8 * c);
        __syncthreads();
        store_kv_tile(shm, kreg, v0, key, c);
        { LAS bf16_t* vt = (LAS bf16_t*)(shm + A_VTS) + (64 + 8 * c) * 68 + key;
          vt[0] = (bf16_t)(v1.x & 0xffff); vt[68] = (bf16_t)(v1.x >> 16); vt[136] = (bf16_t)(v1.y & 0xffff); vt[204] = (bf16_t)(v1.y >> 16);
          vt[272] = (bf16_t)(v1.z & 0xffff); vt[340] = (bf16_t)(v1.z >> 16); vt[408] = (bf16_t)(v1.w & 0xffff); vt[476] = (bf16_t)(v1.w >> 16); }
        __syncthreads();
        if (64 * kt2 <= 32 * qsub + 31) {
            f32x16 s[2]; qk_tile(shm + A_KS, q, r, h, s);
#pragma unroll
            for (int kt = 0; kt < 2; ++kt)
#pragma unroll
                for (int reg = 0; reg < 16; ++reg) { const int kc_ = 64 * kt2 + 32 * kt + (reg & 3) + 8 * (reg >> 2) + 4 * h, diff = qc - kc_;
                    s[kt][reg] = diff >= 0 ? s[kt][reg] * fast_exp2(l2g * (float)diff) : 0.f; }
            pv_tile(shm + A_VTS, 64 * eh, s, r, h, o);
        }
    }
    float s1 = 0.f, s2 = 0.f;
#pragma unroll
    for (int dt = 0; dt < 2; ++dt)
#pragma unroll
        for (int e = 0; e < 16; ++e) { s1 += o[dt][e]; s2 += o[dt][e] * o[dt][e]; }
    s1 += __shfl_xor(s1, 32); s2 += __shfl_xor(s2, 32);
    if (h == 0) part[eh * 128 + qc] = (f32x2){s1, s2};
    __syncthreads();
    const f32x2 pa = part[qc], pb = part[128 + qc];
    const float mean = (pa.x + pb.x) * (1.0f / 128.0f), var = (pa.y + pb.y) * (1.0f / 128.0f) - mean * mean, rstd = rsqrtf(fmaxf(var, 0.f) + 1e-5f);
    const float* gn = P.in[I_GNG] + (size_t)l * 512 + 128 * hd;
    bf16_t* y = (bf16_t*)(P.ws + WS_Y + Y_RET) + ((size_t)b * S_ + qpos) * 512 + 128 * hd;
    const bf16_t* gin = p + (size_t)qc * LDP + C_RETG + 128 * hd;
#pragma unroll
    for (int dt = 0; dt < 2; ++dt)
#pragma unroll
        for (int gg = 0; gg < 4; ++gg) { const int e = 64 * eh + 32 * dt + 8 * gg + 4 * h; const f32x4 g4 = *(const f32x4*)(gn + e); const u32x2 gi = *(const u32x2*)(gin + e);
            const float gv[4] = {bf_lo(gi.x), bf_hi(gi.x), bf_lo(gi.y), bf_hi(gi.y)}; float ov[4];
#pragma unroll
            for (int i = 0; i < 4; ++i) { const float on = (o[dt][4 * gg + i] - mean) * rstd * g4[i]; ov[i] = gv[i] / (1.0f + __expf(-gv[i])) * on; }
            *(u32x2*)(y + e) = (u32x2){cvt_pk_bf16(ov[0], ov[1]), cvt_pk_bf16(ov[2], ov[3])}; }
    __syncthreads();
}

template <int CTRL> __device__ __forceinline__ float dpp_add(float x) { return x + __builtin_bit_cast(float, __builtin_amdgcn_update_dpp(0, __builtin_bit_cast(int, x), CTRL, 0xf, 0xf, true)); }
__device__ __forceinline__ float reduce8(float x) { x = dpp_add<0xB1>(x); x = dpp_add<0x4E>(x); x = dpp_add<0x141>(x); return x; }
__device__ __forceinline__ float reduce16(float x) { x = reduce8(x); x = dpp_add<0x140>(x); return x; }
constexpr int R_R = 0, R_K = 8192, R_V = 16384, R_W = 24576, R_A = 32768, R_KK = 40960, R_KKA = 49152, R_G = 57344, R_Y = 65536, R_RK = 73728,
              R_TW = 73984, R_AL = 78592, R_GL = 83200, R_W2 = 91904, R_A2 = 101120, R_G2 = 110336, R_END = 127744;
__device__ __forceinline__ void rwkv_item(const Params& P, int l, int it, LAS unsigned char* shm) {
    const int tid = opaque_tid(), lane = tid & 63, w = tid >> 6, r = lane & 31, h = lane >> 5;
    const int b = it >> 2, hd = it & 3;
    const bf16_t* p = (const bf16_t*)(P.ws + WS_R1) + (size_t)b * S_ * LDP + C_RWKV;
    const float* mu = P.in[I_MU] + (size_t)l * 1024;
    LAS float* sR = (LAS float*)(shm + R_R); LAS float* sK = (LAS float*)(shm + R_K); LAS float* sV = (LAS float*)(shm + R_V); LAS float* sW = (LAS float*)(shm + R_W);
    LAS float* sA = (LAS float*)(shm + R_A); LAS float* sKK = (LAS float*)(shm + R_KK); LAS float* sKKA = (LAS float*)(shm + R_KKA); LAS float* sG = (LAS float*)(shm + R_G);
    LAS float* sY = (LAS float*)(shm + R_Y); LAS float* sRK = (LAS float*)(shm + R_RK);
    LAS bf16_t* sTW = (LAS bf16_t*)(shm + R_TW); LAS bf16_t* sAL = (LAS bf16_t*)(shm + R_AL); LAS bf16_t* sGL = (LAS bf16_t*)(shm + R_GL);
    LAS bf16_t* W2t = (LAS bf16_t*)(shm + R_W2); LAS bf16_t* A2t = (LAS bf16_t*)(shm + R_A2); LAS bf16_t* G2t = (LAS bf16_t*)(shm + R_G2);
    __syncthreads();
    {
        const float* w2 = P.in[I_W2] + (size_t)l * 64 * 256 + 64 * hd; const float* a2 = P.in[I_A2] + (size_t)l * 64 * 256 + 64 * hd; const float* g2 = P.in[I_G2] + (size_t)l * 128 * 256 + 64 * hd;
        for (int e = tid; e < 4096; e += 512) { const int k = e >> 6, n = e & 63; W2t[n * 72 + k] = (bf16_t)(cvt_pk_bf16(w2[k * 256 + n], 0.f) & 0xffff); A2t[n * 72 + k] = (bf16_t)(cvt_pk_bf16(a2[k * 256 + n], 0.f) & 0xffff); }
        for (int e = tid; e < 8192; e += 512) { const int k = e >> 6, n = e & 63; G2t[n * 136 + k] = (bf16_t)(cvt_pk_bf16(g2[k * 256 + n], 0.f) & 0xffff); }
    }
    int tcol[7], ttok[7];
#pragma unroll
    for (int i = 0; i < 7; ++i) { const int task = tid + 512 * i, tt = task / 112, v = task % 112; ttok[i] = tt;
        tcol[i] = v < 48 ? (v >> 4) * 256 + 64 * hd + 4 * (v & 15) : 768 + 4 * (v - 48); }
    u32x2 cur[7], prv[7];
    auto issue = [&](int ch) {
#pragma unroll
        for (int i = 0; i < 7; ++i) { const int t = 32 * ch + ttok[i]; cur[i] = *(const u32x2*)(p + (size_t)t * LDP + tcol[i]);
            prv[i] = t > 0 ? *(const u32x2*)(p + (size_t)(t - 1) * LDP + tcol[i]) : (u32x2){0u, 0u}; } };
    issue(0);
    float st[8];
#pragma unroll
    for (int i = 0; i < 8; ++i) st[i] = 0.f;
    const int srow = 8 * w + (lane >> 3), scg = lane & 7;
    const int ptok = tid >> 4, pc = (tid & 15) * 4, hc = 64 * hd + pc;
    const f32x4 kk4 = *(const f32x4*)(P.in[I_KK] + (size_t)l * 256 + hc), ka4 = *(const f32x4*)(P.in[I_KA] + (size_t)l * 256 + hc), rk4 = *(const f32x4*)(P.in[I_RK] + (size_t)l * 256 + hc);
    const f32x4 lng4 = *(const f32x4*)(P.in[I_LNG] + (size_t)l * 256 + hc), lnb4 = *(const f32x4*)(P.in[I_LNB] + (size_t)l * 256 + hc);
    bf16_t* yout = (bf16_t*)(P.ws + WS_Y + Y_RWKV) + (size_t)b * S_ * 256 + hc;
    for (int ch = 0; ch < S_ / 32; ++ch) {
#pragma unroll
        for (int i = 0; i < 7; ++i) { const int tt = ttok[i], col = tcol[i]; const f32x4 m4 = *(const f32x4*)(mu + col);
            const float c0 = bf_lo(cur[i].x), c1 = bf_hi(cur[i].x), c2 = bf_lo(cur[i].y), c3 = bf_hi(cur[i].y);
            const float x0 = c0 + m4[0] * (bf_lo(prv[i].x) - c0), x1 = c1 + m4[1] * (bf_hi(prv[i].x) - c1), x2 = c2 + m4[2] * (bf_lo(prv[i].y) - c2), x3 = c3 + m4[3] * (bf_hi(prv[i].y) - c3);
            if (col < 768) { LAS float* dst = (col < 256 ? sR : (col < 512 ? sK : sV)) + tt * 64 + (col & 63); *(LAS f32x4*)dst = (f32x4){x0, x1, x2, x3}; }
            else if (col < 832) *(LAS u32x2*)(sTW + tt * 72 + (col - 768)) = (u32x2){cvt_pk_bf16(tanhf(x0), tanhf(x1)), cvt_pk_bf16(tanhf(x2), tanhf(x3))};
            else if (col < 896) *(LAS u32x2*)(sAL + tt * 72 + (col - 832)) = (u32x2){cvt_pk_bf16(x0, x1), cvt_pk_bf16(x2, x3)};
            else *(LAS u32x2*)(sGL + tt * 136 + (col - 896)) = (u32x2){cvt_pk_bf16(sigmoidf_(x0), sigmoidf_(x1)), cvt_pk_bf16(sigmoidf_(x2), sigmoidf_(x3))}; }
        __syncthreads();
        if (w < 6) { const int mat = w >> 1, ntile = w & 1; f32x16 c = zero16(); const int chn = 32 * ntile + r;
            if (mat == 0) {
#pragma unroll
                for (int ks = 0; ks < 4; ++ks) c = mfma32(*(const LAS bf16x8*)(sTW + r * 72 + 16 * ks + 8 * h), *(const LAS bf16x8*)(W2t + chn * 72 + 16 * ks + 8 * h), c);
                const float w0 = P.in[I_W0][(size_t)l * 256 + 64 * hd + chn];
#pragma unroll
                for (int reg = 0; reg < 16; ++reg) { const int tok = (reg & 3) + 8 * (reg >> 2) + 4 * h; const float val = w0 + c[reg]; const float wv = -logf(1.0f + __expf(-val)) - 0.5f; sW[tok * 64 + chn] = __expf(-__expf(wv)); }
            } else if (mat == 1) {
#pragma unroll
                for (int ks = 0; ks < 4; ++ks) c = mfma32(*(const LAS bf16x8*)(sAL + r * 72 + 16 * ks + 8 * h), *(const LAS bf16x8*)(A2t + chn * 72 + 16 * ks + 8 * h), c);
                const float a0 = P.in[I_A0][(size_t)l * 256 + 64 * hd + chn];
#pragma unroll
                for (int reg = 0; reg < 16; ++reg) { const int tok = (reg & 3) + 8 * (reg >> 2) + 4 * h; sA[tok * 64 + chn] = sigmoidf_(a0 + c[reg]); }
            } else {
#pragma unroll
                for (int ks = 0; ks < 8; ++ks) c = mfma32(*(const LAS bf16x8*)(sGL + r * 136 + 16 * ks + 8 * h), *(const LAS bf16x8*)(G2t + chn * 136 + 16 * ks + 8 * h), c);
#pragma unroll
                for (int reg = 0; reg < 16; ++reg) { const int tok = (reg & 3) + 8 * (reg >> 2) + 4 * h; sG[tok * 64 + chn] = c[reg]; }
            } }
        __syncthreads();
        { const f32x4 k = *(const LAS f32x4*)(sK + ptok * 64 + pc), a = *(const LAS f32x4*)(sA + ptok * 64 + pc), rr = *(const LAS f32x4*)(sR + ptok * 64 + pc);
          const f32x4 kkv = k * kk4; float ss = (kkv[0] * kkv[0] + kkv[1] * kkv[1]) + (kkv[2] * kkv[2] + kkv[3] * kkv[3]); ss = reduce16(ss);
          const float inv = 1.0f / fmaxf(sqrtf(ss), 1e-12f); const f32x4 kk = kkv * inv; const f32x4 kp = k * (1.0f + (a - 1.0f) * ka4);
          float rk = (rr[0] * kp[0] * rk4[0] + rr[1] * kp[1] * rk4[1]) + (rr[2] * kp[2] * rk4[2] + rr[3] * kp[3] * rk4[3]); rk = reduce16(rk);
          *(LAS f32x4*)(sKK + ptok * 64 + pc) = kk; *(LAS f32x4*)(sKKA + ptok * 64 + pc) = kk * a; *(LAS f32x4*)(sK + ptok * 64 + pc) = kp;
          if ((tid & 15) == 0) sRK[ptok] = rk; }
        __syncthreads();
        if (ch + 1 < S_ / 32) issue(ch + 1);
#pragma unroll 2
        for (int tt = 0; tt < 32; ++tt) {
            const LAS f32x4* pw = (const LAS f32x4*)(sW + tt * 64 + 8 * scg); const LAS f32x4* pk = (const LAS f32x4*)(sKK + tt * 64 + 8 * scg); const LAS f32x4* pa = (const LAS f32x4*)(sKKA + tt * 64 + 8 * scg);
            const LAS f32x4* pp = (const LAS f32x4*)(sK + tt * 64 + 8 * scg); const LAS f32x4* pr = (const LAS f32x4*)(sR + tt * 64 + 8 * scg);
            const f32x4 w0 = pw[0], w1 = pw[1], k0 = pk[0], k1 = pk[1], a0 = pa[0], a1 = pa[1], p0 = pp[0], p1 = pp[1], r0 = pr[0], r1 = pr[1];
            const float v = sV[tt * 64 + srow];
            float sa = ((st[0] * k0[0] + st[1] * k0[1]) + (st[2] * k0[2] + st[3] * k0[3])) + ((st[4] * k1[0] + st[5] * k1[1]) + (st[6] * k1[2] + st[7] * k1[3]));
            sa = -reduce8(sa);
#pragma unroll
            for (int i = 0; i < 4; ++i) { st[i] = st[i] * w0[i] + sa * a0[i] + v * p0[i]; st[4 + i] = st[4 + i] * w1[i] + sa * a1[i] + v * p1[i]; }
            float y = ((st[0] * r0[0] + st[1] * r0[1]) + (st[2] * r0[2] + st[3] * r0[3])) + ((st[4] * r1[0] + st[5] * r1[1]) + (st[6] * r1[2] + st[7] * r1[3]));
            y = reduce8(y);
            if (scg == 0) sY[tt * 64 + srow] = y;
        }
        __syncthreads();
        { const f32x4 y = *(const LAS f32x4*)(sY + ptok * 64 + pc); float s1 = (y[0] + y[1]) + (y[2] + y[3]); s1 = reduce16(s1); const float mean = s1 * (1.0f / 64.0f);
          const f32x4 d = y - mean; float s2 = (d[0] * d[0] + d[1] * d[1]) + (d[2] * d[2] + d[3] * d[3]); s2 = reduce16(s2); const float rstd = rsqrtf(s2 * (1.0f / 64.0f) + 64e-5f);
          const f32x4 vv = *(const LAS f32x4*)(sV + ptok * 64 + pc), g = *(const LAS f32x4*)(sG + ptok * 64 + pc); const float rk = sRK[ptok];
          const f32x4 ov = (d * rstd * lng4 + lnb4 + rk * vv) * g;
          *(u32x2*)(yout + (size_t)(32 * ch + ptok) * 256) = (u32x2){cvt_pk_bf16(ov[0], ov[1]), cvt_pk_bf16(ov[2], ov[3])}; }
        __syncthreads();
    }
}

constexpr int LDS_BYTES = 147456, L_ITEM = 140000;
__device__ __forceinline__ void phase_cmp2(const Params& P, int l, int bid, int nb) {
    const int ctid = opaque_tid();
    for (int o = bid * 512 + ctid; o < 2 * 2048 * 64; o += nb * 512) {
        const int kv = o >> 17, m = (o >> 6) & 2047, j = o & 63;
        const bf16_t* hrow = (const bf16_t*)(P.ws + WS_Z3 + (kv ? M_H1V : M_H1K)) + (size_t)m * 256;
        const float* w2 = P.in[kv ? I_CVW2 : I_CKW2] + (size_t)l * 256 * 64 + j; float s = 0.f;
#pragma unroll 4
        for (int i = 0; i < 256; i += 8) { const u32x4 hv = *(const u32x4*)(hrow + i); const unsigned ww[4] = {hv.x, hv.y, hv.z, hv.w};
#pragma unroll
            for (int e = 0; e < 4; ++e) { s += bf_lo(ww[e]) * w2[(size_t)(i + 2 * e) * 64]; s += bf_hi(ww[e]) * w2[(size_t)(i + 2 * e + 1) * 64]; } }
        ((bf16_t*)(P.ws + WS_Z3 + (kv ? M_VC : M_KC)))[(size_t)m * 64 + j] = (bf16_t)(cvt_pk_bf16(s, 0.f) & 0xffff);
    }
}

__global__ void __launch_bounds__(512, 2) fwd_megakernel(Params P) {
    extern __shared__ __attribute__((aligned(16))) unsigned char shm_raw[];
    LAS unsigned char* shm = (LAS unsigned char*)shm_raw;
    cg::grid_group grid = cg::this_grid();
    const int bid = blockIdx.x, nb = gridDim.x;
#define ws (opq_ptr(P.ws))
#define W ((bf16_t*)(ws + WS_W))
#define H ((bf16_t*)(ws + WS_H))
#define R1 ((bf16_t*)(ws + WS_R1))
#define Fb ((bf16_t*)(ws + WS_R1 + R1_F))
#define Yb ((bf16_t*)(ws + WS_Y))
#define Z3 ((bf16_t*)(ws + WS_Z3))
#define ctr ((unsigned*)(ws + WS_MISC + X_CTR))
    phase_rowpass(P.in[I_X], nullptr, nullptr, 0.f, P.out, P.in[I_F1PRE], H, bid, nb);
    phase_convert(P, 0, shm, bid, nb);
    grid.sync();
    for (int l = 0; l < 2; ++l) {
        run_gemm(shm, H, DM, W + W_GU1, T_, 5632, DM, EpiSwiGLU{R1}, nb, bid);
        grid.sync();
        run_gemm(shm, R1, FF, W + W_D1, T_, DM, FF, EpiPlain{Fb, DM}, nb, bid);
        grid.sync();
        phase_rowpass(P.out, Fb, P.in[I_F1POST] + (size_t)l * DM, 0.5f, P.out, P.in[I_MPRE] + (size_t)l * DM, H, bid, nb);
        grid.sync();
        run_gemm(shm, H, DM, W + W_IN, T_, LDP, DM, EpiWin{R1, (bf16_t*)(ws + WS_Z3 + M_KCIN), (bf16_t*)(ws + WS_Z3 + M_VCIN), (const f32x2*)(ws + WS_MISC + X_ROPE)}, nb, bid);
        grid.sync();
        if (bid < 8) run_gemm(shm, (const bf16_t*)(ws + WS_Z3 + M_KCIN), 1024, W + W_CK1, 2048, 256, 2048, EpiGelu{(bf16_t*)(ws + WS_Z3 + M_H1K), (const float*)(ws + WS_MISC + X_CB)}, 8, bid);
        else if (bid < 16) run_gemm(shm, (const bf16_t*)(ws + WS_Z3 + M_VCIN), 1024, W + W_CV1, 2048, 256, 2048, EpiGelu{(bf16_t*)(ws + WS_Z3 + M_H1V), (const float*)(ws + WS_MISC + X_CB) + 256}, 8, bid - 8);
        for (int it = bid; it < 1536; it += nb) { if (it < 1024) ret_kv_item(P, it, shm); else swa_item(P, l, it - 1024, shm); }
        grid.sync();
        phase_cmp2(P, l, bid, nb);
        grid.sync();
        for (int it = bid; it < 512; it += nb) nsa_cmp_item(P, it, shm);
        grid.sync();
        for (int it = bid; it < 32; it += nb) rwkv_item(P, l, it, shm);
        for (;;) {
            __syncthreads();
            if (opaque_tid() == 0) *(LAS int*)(shm + L_ITEM) = (int)atomicAdd(ctr + l, 1u);
            __syncthreads();
            const int it = *(LAS int*)(shm + L_ITEM);
            if (it >= 1536) break;
            if (it < 512) nsa_selwin_item(P, it, shm); else ret_out_item(P, l, it - 512, shm);
        }
        grid.sync();
        run_gemm(shm, Yb, 256, W + W_PNSA, T_, DM, 256, EpiPlain{R1, DM}, nb, bid);
        run_gemm(shm, (const bf16_t*)(ws + WS_Y + Y_RET), 512, W + W_PRET, T_, DM, 512, EpiPlain{R1 + (size_t)T_ * DM, DM}, nb, bid);
        run_gemm(shm, (const bf16_t*)(ws + WS_Y + Y_RWKV), 256, W + W_PRWKV, T_, DM, 256, EpiPlain{R1 + (size_t)2 * T_ * DM, DM}, nb, bid);
        run_gemm(shm, (const bf16_t*)(ws + WS_Y + Y_SWA), 256, W + W_PSWA, T_, DM, 256, EpiPlain{Z3, DM}, nb, bid);
        grid.sync();
        run_gemm(shm, H, DM, W + W_GATE, T_, 4096, DM, EpiMerge{{R1, R1 + (size_t)T_ * DM, R1 + (size_t)2 * T_ * DM, Z3}, Yb}, nb, bid);
        grid.sync();
        run_gemm(shm, Yb, DM, W + W_OUT, T_, DM, DM, EpiPlain{Fb, DM}, nb, bid);
        grid.sync();
        phase_rowpass(P.out, Fb, P.in[I_MPOST] + (size_t)l * DM, 1.0f, P.out, P.in[I_F2PRE] + (size_t)l * DM, H, bid, nb);
        grid.sync();
        run_gemm(shm, H, DM, W + W_GU2, T_, 5632, DM, EpiSwiGLU{R1}, nb, bid);
        grid.sync();
        run_gemm(shm, R1, FF, W + W_D2, T_, DM, FF, EpiPlain{Fb, DM}, nb, bid);
        grid.sync();
        phase_rowpass(P.out, Fb, P.in[I_F2POST] + (size_t)l * DM, 0.5f, P.out, l == 0 ? P.in[I_F1PRE] + DM : nullptr, H, bid, nb);
        if (l == 0) phase_convert(P, 1, shm, bid, nb);
        grid.sync();
    }
}
#undef ws
#undef W
#undef H
#undef R1
#undef Fb
#undef Yb
#undef Z3
#undef ctr

extern "C" void kernel_launch(void* const* d_in, const int* in_sizes, int n_in, void* d_out, int out_size, void* d_ws, size_t ws_size, hipStream_t stream) {
    static int grid_blocks = 0;
    if (grid_blocks == 0) {
        if (n_in != N_IN || out_size != T_ * DM || ws_size < WS_END) { fprintf(stderr, "kernel_launch: unexpected shapes (n_in %d out %d ws %zu)\n", n_in, out_size, ws_size); grid_blocks = -1; return; }
        int dev = 0, cus = 0, per_cu = 0;
        hipGetDevice(&dev); hipDeviceGetAttribute(&cus, hipDeviceAttributeMultiprocessorCount, dev);
        hipFuncSetAttribute((const void*)fwd_megakernel, hipFuncAttributeMaxDynamicSharedMemorySize, LDS_BYTES);
        hipOccupancyMaxActiveBlocksPerMultiprocessor(&per_cu, (const void*)fwd_megakernel, 512, LDS_BYTES);
        if (per_cu < 1) per_cu = 1;
        grid_blocks = cus * per_cu;
    }
    if (grid_blocks < 0) return;
    hipMemsetAsync((char*)d_ws + WS_MISC + X_CTR, 0, 256, stream);
    Params p{};
    for (int i = 0; i < N_IN; ++i) p.in[i] = (const float*)d_in[i];
    p.out = (float*)d_out; p.ws = (unsigned char*)d_ws;
    void* args[] = {&p};
    hipError_t e = hipLaunchCooperativeKernel((const void*)fwd_megakernel, dim3(grid_blocks), dim3(512), args, LDS_BYTES, stream);
    if (e != hipSuccess) fprintf(stderr, "cooperative launch failed: %s (grid %d)\n", hipGetErrorString(e), grid_blocks);
}
```

```cpp
#include <hip/hip_runtime.h>
#include <hip/hip_cooperative_groups.h>
#include <cstdio>
namespace cg = cooperative_groups;

#define LAS __attribute__((address_space(3)))
typedef unsigned short bf16_t;
typedef short bf16x8 __attribute__((ext_vector_type(8)));
typedef float f32x2 __attribute__((ext_vector_type(2)));
typedef float f32x4 __attribute__((ext_vector_type(4)));
typedef float f32x16 __attribute__((ext_vector_type(16)));
typedef unsigned u32x2 __attribute__((ext_vector_type(2)));
typedef unsigned u32x4 __attribute__((ext_vector_type(4)));

constexpr int T_ = 32768, S_ = 4096, NB_ = 8, DM = 1024, FF = 2816, NCOL = 7820, LDP = 3840;
constexpr float LOG2E = 1.4426950408889634f;
constexpr int C_NSAQ = 0, C_KCMP = 256, C_VCMP = 320, C_KSLC = 384, C_VSLC = 448, C_KWIN = 512, C_VWIN = 576, C_NGATE = 640;
constexpr int C_RETQ = 704, C_RETK = 960, C_RETV = 1216, C_RETG = 1728, C_RWKV = 2240, C_SWAQ = 3264, C_SWAK = 3520, C_SWAV = 3648;

enum { I_X = 0, I_F1PRE, I_F1POST, I_F1G, I_F1U, I_F1D, I_MPRE, I_MPOST, I_WIN, I_POSK, I_POSV, I_CKW1, I_CKW2, I_CVW1, I_CVW2, I_GNG,
       I_MU, I_W0, I_W2, I_A0, I_A2, I_G2, I_KK, I_KA, I_RK, I_LNG, I_LNB, I_SINK, I_PNSA, I_PRET, I_PRWKV, I_PSWA, I_WOUT,
       I_F2PRE, I_F2POST, I_F2G, I_F2U, I_F2D, N_IN };

constexpr size_t MiB = 1048576;
constexpr size_t WS_W = 0, WS_H = 56 * MiB, WS_R1 = 120 * MiB, WS_Y = 360 * MiB, WS_Z3 = 440 * MiB, WS_MISC = 504 * MiB, WS_END = 510 * MiB;
constexpr size_t W_GU1 = 0, W_D1 = W_GU1 + (size_t)5632 * 1024, W_IN = W_D1 + (size_t)1024 * 2816, W_GATE = W_IN + (size_t)3840 * 1024,
                 W_PNSA = W_GATE + (size_t)4096 * 1024, W_PRET = W_PNSA + 262144, W_PRWKV = W_PRET + 524288, W_PSWA = W_PRWKV + 262144,
                 W_OUT = W_PSWA + 262144, W_GU2 = W_OUT + 1048576, W_D2 = W_GU2 + (size_t)5632 * 1024, W_CK1 = W_D2 + (size_t)1024 * 2816,
                 W_CV1 = W_CK1 + 524288, W_ENDE = W_CV1 + 524288;
static_assert(W_ENDE * 2 <= 56 * MiB, "weights");
constexpr size_t R1_F = (size_t)T_ * FF * 2;
constexpr size_t Y_NSA = 0, Y_RET = (size_t)T_ * 256 * 2, Y_RWKV = Y_RET + (size_t)T_ * 512 * 2, Y_SWA = Y_RWKV + (size_t)T_ * 256 * 2;
constexpr size_t M_KCIN = 0, M_VCIN = M_KCIN + ((size_t)T_ + 64) * 64 * 2, M_H1K = M_VCIN + ((size_t)T_ + 64) * 64 * 2, M_H1V = M_H1K + 2048 * 256 * 2,
                 M_KC = M_H1V + 2048 * 256 * 2, M_VC = M_KC + 2048 * 64 * 2, M_SEL = M_VC + 2048 * 64 * 2, M_KV = M_SEL + (size_t)T_ * 8,
                 M_A1 = M_KV + (size_t)1024 * 8192 * 2, M_A2 = M_A1 + (size_t)T_ * 256 * 2, M_END = M_A2 + (size_t)T_ * 256 * 2;
static_assert(M_END <= 64 * MiB, "mixer scratch");
constexpr size_t X_ROPE = 0, X_CB = X_ROPE + (size_t)S_ * 32 * 8, X_CTR = X_CB + 4096;
constexpr size_t X_FLAG = X_CTR + 256, X_XB = X_FLAG + 128 * 64, X_CBP = X_XB + 131072;

struct Params { const float* in[N_IN]; float* out; unsigned char* ws; };

typedef __bf16 bf16x2v __attribute__((ext_vector_type(2)));
__device__ __forceinline__ unsigned cvt_pk_bf16(float lo, float hi) { const f32x2 v = (f32x2){lo, hi}; const bf16x2v b = __builtin_convertvector(v, bf16x2v); return __builtin_bit_cast(unsigned, b); }
__device__ __forceinline__ float bf_lo(unsigned u) { return __uint_as_float(u << 16); }
__device__ __forceinline__ float bf_hi(unsigned u) { return __uint_as_float(u & 0xffff0000u); }
__device__ __forceinline__ float bf2f(bf16_t b) { return __uint_as_float(((unsigned)b) << 16); }
__device__ __forceinline__ float fast_exp2(float x) { return __builtin_amdgcn_exp2f(x); }
__device__ __forceinline__ float sigmoidf_(float x) { return __builtin_amdgcn_rcpf(1.0f + __builtin_amdgcn_exp2f(-1.4426950408889634f * x)); }
__device__ __forceinline__ float fast_sigmoid(float x) { return __builtin_amdgcn_rcpf(1.0f + __builtin_amdgcn_exp2f(-1.4426950408889634f * x)); }
__device__ __forceinline__ float fast_tanh(float x) { return 1.0f - 2.0f * __builtin_amdgcn_rcpf(1.0f + __builtin_amdgcn_exp2f(2.8853900817779268f * x)); }
template <int CTRL> __device__ __forceinline__ float dpp_add_(float x) { return x + __builtin_bit_cast(float, __builtin_amdgcn_update_dpp(0, __builtin_bit_cast(int, x), CTRL, 0xf, 0xf, true)); }
__device__ __forceinline__ float wave_sum(float v) {
    v = dpp_add_<0xB1>(v); v = dpp_add_<0x4E>(v); v = dpp_add_<0x141>(v); v = dpp_add_<0x140>(v);
    v += __shfl_xor(v, 16); v += __shfl_xor(v, 32);
    return v;
}
__device__ __forceinline__ int opaque_tid(int wv) { int lane_; asm volatile("v_mbcnt_lo_u32_b32 %0, -1, 0\n\tv_mbcnt_hi_u32_b32 %0, -1, %0" : "=v"(lane_)); return (wv << 6) | lane_; }
__device__ __forceinline__ unsigned char* opq_ptr(unsigned char* p) { asm volatile("" : "+s"(p)); return p; }
__device__ __forceinline__ f32x16 mfma32(bf16x8 a, bf16x8 b, f32x16 c) { return __builtin_amdgcn_mfma_f32_32x32x16_bf16(a, b, c, 0, 0, 0); }
__device__ __forceinline__ f32x16 zero16() { f32x16 z;
#pragma unroll
    for (int i = 0; i < 16; ++i) z[i] = 0.f;
    return z; }

namespace pg8 {
constexpr int BM = 256, BK = 64, HALF = 128, HTB = HALF * BK * 2, STAGE_BYTES = 8 * HTB, NXCD = 8, WGM = 8;
__device__ __forceinline__ int lds_byte(int r, int c) { const int st = (r >> 4) * 2 + (c >> 5), rr = r & 15, cc = c & 31, ob = rr * 64 + cc * 2; return st * 1024 + (ob ^ (((ob >> 9) & 1) << 5)); }
__device__ __forceinline__ void stage_rc(int b, int& R, int& C) { const int st = b / 1024, sb = b % 1024, swz = sb ^ (((sb >> 9) & 1) << 5); R = (st >> 1) * 16 + swz / 64; C = (st & 1) * 32 + (swz % 64) / 2; }
struct Unit { int pm, pn; };
struct Gemm { const bf16_t* A; const bf16_t* Bt; int M, N, K, lda; };
struct StaticOrder {
    int nM, nN, nwg, G, c, rev;
    __device__ void init(int M, int N, int G_, int c_, int rev_ = 0) { nM = M / BM; nN = N / BM; nwg = nM * nN; G = G_; c = c_; rev = rev_; }
    __device__ bool next(int i, Unit& u) const {
        const long L = (long)i * G + c; if (c < 0 || L >= nwg) return false;
        int wgid = (int)L; { const int q = nwg / NXCD, r = nwg % NXCD, xcd = wgid % NXCD, off = wgid / NXCD; wgid = (xcd < r ? xcd * (q + 1) : r * (q + 1) + (xcd - r) * q) + off; }
        const int nig = WGM * nN, gid = wgid / nig, fm = gid * WGM, gsz = (nM - fm) < WGM ? (nM - fm) : WGM;
        u.pm = fm + ((wgid % nig) % gsz); u.pn = (wgid % nig) / gsz; if (rev) u.pm = nM - 1 - u.pm;
        return true;
    }
};
template <class Epi, class Sched>
__device__ __forceinline__ void gemm_phase(LAS unsigned char* lds, const Gemm g, const Sched& S, const Epi& E, int wv__) {
    const int tid = opaque_tid(wv__), wid = __builtin_amdgcn_readfirstlane(tid >> 6), lane = tid & 63, wr = wid >> 2, wc = wid & 3, fr = lane & 15, fq = lane >> 4;
    const int K = g.K, nt = K / BK, lda = g.lda;
    unsigned voffA[2], voffB[2];
#pragma unroll
    for (int i = 0; i < 2; ++i) { int R, C; stage_rc(tid * 16 + i * 8192, R, C); voffA[i] = (unsigned)(R * lda + C) * 2u; voffB[i] = (unsigned)(R * K + C) * 2u; }
    const size_t kstep = (size_t)(BK * 2);
    const size_t hstepA = (size_t)HALF * lda * 2, hstepB = (size_t)HALF * K * 2;
    const size_t tstepA = 2 * hstepA, tstepB = 2 * hstepB;
    const unsigned ldsw = (unsigned)wid * 1024u;
    const int aoff = lds_byte(wr * 64 + fr, fq * 8), boff = lds_byte(wc * 32 + fr, fq * 8);
#define PG8_SA(b, h) (((b) * 2 + (h)) * HTB)
#define PG8_SB(b, h) ((4 + (b) * 2 + (h)) * HTB)
#define PG8_STAGE(bufoff, gbase, voff) do { _Pragma("unroll") for (int _i = 0; _i < 2; ++_i) \
        __builtin_amdgcn_global_load_lds((const unsigned*)((const char*)(gbase) + (voff)[_i]), (LAS unsigned*)(lds + (bufoff) + ldsw + _i * 8192), 16, 0, 0); } while (0)
#define PG8_LDA(dst, b, h) do { _Pragma("unroll") for (int m = 0; m < 4; ++m) _Pragma("unroll") for (int k = 0; k < 2; ++k) dst[m][k] = *(const LAS bf16x8*)(lds + PG8_SA(b, h) + aoff + m * 2048 + k * 1024); } while (0)
#define PG8_LDB(dst, b, h) do { _Pragma("unroll") for (int n = 0; n < 2; ++n) _Pragma("unroll") for (int k = 0; k < 2; ++k) dst[n][k] = *(const LAS bf16x8*)(lds + PG8_SB(b, h) + boff + n * 2048 + k * 1024); } while (0)
#define PG8_MMA(ai, bj, At, Bt) do { __builtin_amdgcn_s_setprio(1); _Pragma("unroll") for (int m = 0; m < 4; ++m) _Pragma("unroll") for (int n = 0; n < 2; ++n) _Pragma("unroll") for (int k = 0; k < 2; ++k) \
        acc[ai][bj][m][n] = __builtin_amdgcn_mfma_f32_16x16x32_bf16(Bt[n][k], At[m][k], acc[ai][bj][m][n], 0, 0, 0); __builtin_amdgcn_s_setprio(0); } while (0)
#define PG8_WAIT_V(n) asm volatile("s_waitcnt vmcnt(" #n ")" ::: "memory")
#define PG8_WAIT_L(n) asm volatile("s_waitcnt lgkmcnt(" #n ")" ::: "memory")
#define PG8_BAR __builtin_amdgcn_s_barrier()
#define PG8_SCHED __builtin_amdgcn_sched_barrier(0)
    Unit cur, nxt; int ui = 0;
    (void)S.next(0, cur);
    f32x4 acc[2][2][4][2];
#pragma unroll
    for (int a = 0; a < 2; ++a)
#pragma unroll
        for (int b = 0; b < 2; ++b)
#pragma unroll
            for (int m = 0; m < 4; ++m)
#pragma unroll
                for (int n = 0; n < 2; ++n) acc[a][b][m][n] = (f32x4){0.f, 0.f, 0.f, 0.f};
    bf16x8 At[4][2], B0[2][2], B1[2][2];
    const char* cA = (const char*)g.A + (size_t)cur.pm * tstepA; const char* cB = (const char*)g.Bt + (size_t)cur.pn * tstepB;
    PG8_STAGE(PG8_SB(0, 0), cB, voffB); PG8_STAGE(PG8_SA(0, 0), cA, voffA); PG8_STAGE(PG8_SB(0, 1), cB + hstepB, voffB); PG8_STAGE(PG8_SA(0, 1), cA + hstepA, voffA);
    if (wr == 1) PG8_BAR;
    PG8_WAIT_V(4); PG8_BAR;
    PG8_STAGE(PG8_SB(1, 0), cB + kstep, voffB); PG8_STAGE(PG8_SA(1, 0), cA + kstep, voffA); PG8_STAGE(PG8_SB(1, 1), cB + hstepB + kstep, voffB);
    PG8_WAIT_V(6); PG8_BAR;
    for (;;) {
        const bool has_next = S.next(ui + 1, nxt);
        const char* nA = has_next ? (const char*)g.A + (size_t)nxt.pm * tstepA : cA; const char* nB = has_next ? (const char*)g.Bt + (size_t)nxt.pn * tstepB : cB;
        for (int t = 0; t < nt; t += 2) {
            const bool last = (t == nt - 2);
            const char* a1 = cA + (size_t)(t + 1) * kstep;
            const char* a2 = last ? nA : cA + (size_t)(t + 2) * kstep; const char* b2 = last ? nB : cB + (size_t)(t + 2) * kstep;
            const char* a3 = a2 + kstep; const char* b3 = b2 + kstep;
            PG8_LDB(B0, 0, 0); PG8_SCHED; PG8_LDA(At, 0, 0); PG8_STAGE(PG8_SA(1, 1), a1 + hstepA, voffA);
            PG8_WAIT_L(8); PG8_BAR; PG8_WAIT_L(0); PG8_MMA(0, 0, At, B0); PG8_BAR; PG8_SCHED;
            PG8_LDB(B1, 0, 1); PG8_STAGE(PG8_SB(0, 0), b2, voffB);
            PG8_BAR; PG8_WAIT_L(0); PG8_MMA(0, 1, At, B1); PG8_BAR;
            PG8_LDA(At, 0, 1); PG8_STAGE(PG8_SA(0, 0), a2, voffA);
            PG8_BAR; PG8_WAIT_L(0); PG8_MMA(1, 0, At, B0); PG8_BAR; PG8_SCHED;
            PG8_STAGE(PG8_SB(0, 1), b2 + hstepB, voffB);
            PG8_WAIT_V(6); PG8_BAR; PG8_MMA(1, 1, At, B1); PG8_BAR;
            PG8_LDB(B0, 1, 0); PG8_SCHED; PG8_LDA(At, 1, 0); PG8_STAGE(PG8_SA(0, 1), a2 + hstepA, voffA);
            PG8_WAIT_L(8); PG8_BAR; PG8_WAIT_L(0); PG8_MMA(0, 0, At, B0); PG8_BAR; PG8_SCHED;
            PG8_LDB(B1, 1, 1); PG8_STAGE(PG8_SB(1, 0), b3, voffB);
            PG8_BAR; PG8_WAIT_L(0); PG8_MMA(0, 1, At, B1); PG8_BAR;
            PG8_LDA(At, 1, 1); PG8_STAGE(PG8_SA(1, 0), a3, voffA);
            PG8_BAR; PG8_WAIT_L(0); PG8_MMA(1, 0, At, B0); PG8_BAR; PG8_SCHED;
            PG8_STAGE(PG8_SB(1, 1), b3 + hstepB, voffB);
            PG8_WAIT_V(6); PG8_BAR; PG8_MMA(1, 1, At, B1); PG8_BAR;
        }
        E(acc, cur, wr, wc, fr, fq);
        if (!has_next) break;
#pragma unroll
        for (int a = 0; a < 2; ++a)
#pragma unroll
            for (int b = 0; b < 2; ++b)
#pragma unroll
                for (int m = 0; m < 4; ++m)
#pragma unroll
                    for (int n = 0; n < 2; ++n) acc[a][b][m][n] = (f32x4){0.f, 0.f, 0.f, 0.f};
        cur = nxt; cA = nA; cB = nB; ++ui;
    }
    PG8_WAIT_V(0);
    if (wr == 0) PG8_BAR;
    PG8_BAR;
#undef PG8_SA
#undef PG8_SB
#undef PG8_STAGE
#undef PG8_LDA
#undef PG8_LDB
#undef PG8_MMA
#undef PG8_WAIT_V
#undef PG8_WAIT_L
#undef PG8_BAR
#undef PG8_SCHED
}
}
using pg8::Unit;
typedef f32x4 AccT[2][2][4][2];

struct EpiPlain {
    bf16_t* O; int ldc;
    __device__ __forceinline__ void operator()(const AccT& acc, const Unit& u, int wr, int wc, int fr, int fq) const {
        const int row0 = u.pm * 256 + wr * 64 + fr, col0 = u.pn * 256 + wc * 32 + 4 * fq;
#pragma unroll
        for (int ai = 0; ai < 2; ++ai)
#pragma unroll
            for (int m = 0; m < 4; ++m) { bf16_t* rowp = O + (size_t)(row0 + ai * 128 + m * 16) * ldc + col0;
#pragma unroll
                for (int bj = 0; bj < 2; ++bj)
#pragma unroll
                    for (int n = 0; n < 2; ++n) { const f32x4 v = acc[ai][bj][m][n]; *(u32x2*)(rowp + bj * 128 + n * 16) = (u32x2){cvt_pk_bf16(v[0], v[1]), cvt_pk_bf16(v[2], v[3])}; } }
    }
};
struct EpiSwiGLU {
    bf16_t* O;
    __device__ __forceinline__ void operator()(const AccT& acc, const Unit& u, int wr, int wc, int fr, int fq) const {
        const int row0 = u.pm * 256 + wr * 64 + fr, col0 = u.pn * 128 + wc * 32 + 4 * fq;
#pragma unroll
        for (int ai = 0; ai < 2; ++ai)
#pragma unroll
            for (int m = 0; m < 4; ++m) { bf16_t* rowp = O + (size_t)(row0 + ai * 128 + m * 16) * FF + col0;
#pragma unroll
                for (int n = 0; n < 2; ++n) { const f32x4 g = acc[ai][0][m][n], up = acc[ai][1][m][n]; float r[4];
#pragma unroll
                    for (int i = 0; i < 4; ++i) r[i] = g[i] * up[i] * fast_sigmoid(g[i]);
                    *(u32x2*)(rowp + n * 16) = (u32x2){cvt_pk_bf16(r[0], r[1]), cvt_pk_bf16(r[2], r[3])}; } }
    }
};
struct EpiGelu {
    bf16_t* O; const float* bias;
    __device__ __forceinline__ void operator()(const AccT& acc, const Unit& u, int wr, int wc, int fr, int fq) const {
        const int row0 = u.pm * 256 + wr * 64 + fr, col0 = u.pn * 256 + wc * 32 + 4 * fq;
#pragma unroll
        for (int ai = 0; ai < 2; ++ai)
#pragma unroll
            for (int m = 0; m < 4; ++m) { bf16_t* rowp = O + (size_t)(row0 + ai * 128 + m * 16) * 256 + col0;
#pragma unroll
                for (int bj = 0; bj < 2; ++bj)
#pragma unroll
                    for (int n = 0; n < 2; ++n) { const f32x4 v = acc[ai][bj][m][n]; const f32x4 b = *(const f32x4*)(bias + col0 + bj * 128 + n * 16); float r[4];
#pragma unroll
                        for (int i = 0; i < 4; ++i) { const float x = v[i] + b[i]; const float u2 = 1.5957691216057308f * (x + 0.044715f * x * x * x); r[i] = x * sigmoidf_(u2); }
                        *(u32x2*)(rowp + bj * 128 + n * 16) = (u32x2){cvt_pk_bf16(r[0], r[1]), cvt_pk_bf16(r[2], r[3])}; } }
    }
};
struct EpiWin {
    bf16_t* P; bf16_t* kcin; bf16_t* vcin; const f32x2* rope;
    __device__ __forceinline__ static bool roped(int hb) { return hb == C_KSLC || hb == C_KWIN || (hb >= C_RETK && hb < C_RETV) || (hb >= C_SWAK && hb < C_SWAV); }
    __device__ __forceinline__ void operator()(const AccT& acc, const Unit& u, int wr, int wc, int fr, int fq) const {
        const int row0 = u.pm * 256 + wr * 64 + fr;
#pragma unroll
        for (int bj = 0; bj < 2; ++bj) {
            const int base = u.pn * 256 + bj * 128 + wc * 32;
            const int hb = base & ~63;
            if (roped(hb)) {
                const int d1 = 16 * (wc & 1) + 4 * fq;
#pragma unroll
                for (int ai = 0; ai < 2; ++ai)
#pragma unroll
                    for (int m = 0; m < 4; ++m) { const int row = row0 + ai * 128 + m * 16; const f32x2* cs = rope + (size_t)(row & (S_ - 1)) * 32 + d1;
                        const f32x4 c01 = *(const f32x4*)cs, c23 = *(const f32x4*)(cs + 2);
                        const f32x4 a = acc[ai][bj][m][0], b = acc[ai][bj][m][1];
                        const float co[4] = {c01[0], c01[2], c23[0], c23[2]}, si[4] = {c01[1], c01[3], c23[1], c23[3]}; float o1[4], o2[4];
#pragma unroll
                        for (int i = 0; i < 4; ++i) { o1[i] = a[i] * co[i] - b[i] * si[i]; o2[i] = b[i] * co[i] + a[i] * si[i]; }
                        bf16_t* rp = P + (size_t)row * LDP + hb + d1;
                        *(u32x2*)rp = (u32x2){cvt_pk_bf16(o1[0], o1[1]), cvt_pk_bf16(o1[2], o1[3])};
                        *(u32x2*)(rp + 32) = (u32x2){cvt_pk_bf16(o2[0], o2[1]), cvt_pk_bf16(o2[2], o2[3])}; }
            } else {
#pragma unroll
                for (int ai = 0; ai < 2; ++ai)
#pragma unroll
                    for (int m = 0; m < 4; ++m) { const int row = row0 + ai * 128 + m * 16;
#pragma unroll
                        for (int n = 0; n < 2; ++n) { const int col = base + n * 16 + 4 * fq; const f32x4 v = acc[ai][bj][m][n];
                            const u32x2 w = (u32x2){cvt_pk_bf16(v[0], v[1]), cvt_pk_bf16(v[2], v[3])};
                            *(u32x2*)(P + (size_t)row * LDP + col) = w;
                            if (hb == C_KCMP) *(u32x2*)(kcin + (size_t)row * 64 + (col - C_KCMP)) = w;
                            if (hb == C_VCMP) *(u32x2*)(vcin + (size_t)row * 64 + (col - C_VCMP)) = w; } }
            }
        }
    }
};
struct EpiMerge {
    const bf16_t* Z[4]; bf16_t* O;
    __device__ __forceinline__ void operator()(const AccT& acc, const Unit& u, int wr, int wc, int fr, int fq) const {
        const int row0 = u.pm * 256 + wr * 64 + fr, col = u.pn * 64 + wc * 16 + 4 * fq;
#pragma unroll
        for (int ai = 0; ai < 2; ++ai) {
            u32x2 zz[4][4];
#pragma unroll
            for (int m = 0; m < 4; ++m) { const size_t off = (size_t)(row0 + ai * 128 + m * 16) * DM + col;
#pragma unroll
                for (int br = 0; br < 4; ++br) zz[m][br] = *(const u32x2*)(Z[br] + off); }
#pragma unroll
            for (int m = 0; m < 4; ++m) { const size_t off = (size_t)(row0 + ai * 128 + m * 16) * DM + col; float r[4] = {0.f, 0.f, 0.f, 0.f};
#pragma unroll
                for (int br = 0; br < 4; ++br) { const f32x4 g = acc[ai][br >> 1][m][br & 1]; const u32x2 z = zz[m][br];
                    r[0] += fast_sigmoid(g[0]) * bf_lo(z[0]); r[1] += fast_sigmoid(g[1]) * bf_hi(z[0]); r[2] += fast_sigmoid(g[2]) * bf_lo(z[1]); r[3] += fast_sigmoid(g[3]) * bf_hi(z[1]); }
                *(u32x2*)(O + off) = (u32x2){cvt_pk_bf16(r[0], r[1]), cvt_pk_bf16(r[2], r[3])}; }
        }
    }
};

template <class Epi>
__device__ __forceinline__ void run_gemm(LAS unsigned char* lds, const bf16_t* A, int lda, const bf16_t* Bt, int M, int N, int K, const Epi& E, int G, int c, int wv__, int rev = 0) {
    pg8::Gemm g; g.A = A; g.Bt = Bt; g.M = M; g.N = N; g.K = K; g.lda = lda;
    pg8::StaticOrder S; S.init(M, N, G, c, rev);
    pg8::gemm_phase<Epi, pg8::StaticOrder>(lds, g, S, E, wv__);
}

struct MapId { const float* src; int ld; __device__ const float* ptr(int n) const { return src + n; } };
struct MapGU { const float* g; const float* u; int ld; __device__ const float* ptr(int n) const { const int j = n >> 8, w = n & 255; return (w < 128) ? g + 128 * j + w : u + 128 * j + (w - 128); } };
__device__ __forceinline__ int swap45(int x) { return (x & ~48) | ((x & 16) << 1) | ((x & 32) >> 1); }
struct MapWin { const float* src; int ld;
    __device__ const float* ptr(int n) const {
        if (n >= 3776 || (n >= 652 && n < 704)) return nullptr;
        const int hb = n & ~63; int c = n;
        if (EpiWin::roped(hb)) c = hb + swap45(n - hb);
        return src + (c < 652 ? c : c - 52); } };
struct MapGate { const float* src; int ld;
    __device__ const float* ptr(int n) const { const int pn = n >> 8, rho = n & 255, bj = rho >> 7, wc = (rho >> 5) & 3, nn = (rho >> 4) & 1, q = rho & 15;
        return src + 3724 + (2 * bj + nn) * 1024 + 64 * pn + 16 * wc + q; } };

template <class Map>
__device__ __forceinline__ void conv_tiles(const Map mp, int K, int N, bf16_t* dst, LAS float* tile, int& item_base, int bid, int nb, int wv__) {
    const int nn = N / 64, total = (K / 64) * nn, tid = opaque_tid(wv__);
    const int first = (bid - (item_base % nb) + nb) % nb;
    const int ty = tid >> 6, tx = tid & 63, wn = tid >> 3, kc = tid & 7;
    for (int it0 = first; it0 < total; it0 += 4 * nb) {
#pragma unroll
        for (int u = 0; u < 4; ++u) { const int it = it0 + u * nb; if (it < total) { const int k0 = (it / nn) * 64, n0 = (it % nn) * 64; const float* sp = mp.ptr(n0 + tx); LAS float* tl = tile + u * 4160;
#pragma unroll
            for (int kk = ty; kk < 64; kk += 8) tl[kk * 65 + tx] = sp ? sp[(size_t)(k0 + kk) * mp.ld] : 0.f; } }
        __syncthreads();
#pragma unroll
        for (int u = 0; u < 4; ++u) { const int it = it0 + u * nb; if (it < total) { const int k0 = (it / nn) * 64, n0 = (it % nn) * 64; const LAS float* sl = tile + u * 4160 + (8 * kc) * 65 + wn;
            u32x4 o; o.x = cvt_pk_bf16(sl[0], sl[65]); o.y = cvt_pk_bf16(sl[2 * 65], sl[3 * 65]); o.z = cvt_pk_bf16(sl[4 * 65], sl[5 * 65]); o.w = cvt_pk_bf16(sl[6 * 65], sl[7 * 65]);
            *(u32x4*)(dst + (size_t)(n0 + wn) * K + k0 + 8 * kc) = o; } }
        __syncthreads();
    }
    item_base += total;
}

__device__ __forceinline__ void phase_convert(const Params& P, int l, LAS unsigned char* lds, int bid, int nb, int wv__) {
    const int ctid = opaque_tid(wv__); bf16_t* W = (bf16_t*)(P.ws + WS_W); LAS float* tile = (LAS float*)lds;
    {
        constexpr int NM = 13;
        const int mK[NM] = {DM, FF, DM, DM, 256, 512, 256, 256, DM, DM, FF, 2048, 2048};
        const int mN[NM] = {5632, DM, LDP, 4096, DM, DM, DM, DM, DM, 5632, DM, 256, 256};
        const size_t mD[NM] = {W_GU1, W_D1, W_IN, W_GATE, W_PNSA, W_PRET, W_PRWKV, W_PSWA, W_OUT, W_GU2, W_D2, W_CK1, W_CV1};
        int total = 0;
#pragma unroll
        for (int m = 0; m < NM; ++m) total += (mK[m] / 64) * (mN[m] / 64);
        const int ty = ctid >> 6, tx = ctid & 63, wn = ctid >> 3, kc = ctid & 7;
        const float* win = P.in[I_WIN] + (size_t)l * DM * NCOL;
        int tk0[4], tn0[4], tm[4]; float vals[4][8];
        auto decode_load = [&](int g0) {
#pragma unroll
            for (int u = 0; u < 4; ++u) { int g = g0 + u * nb; tm[u] = -1; tk0[u] = 0; tn0[u] = 0;
                if (g < total) {
#pragma unroll
                    for (int m = 0; m < NM; ++m) { const int nn = mN[m] / 64, cnt = (mK[m] / 64) * nn; if (tm[u] < 0) { if (g < cnt) { tm[u] = m; tk0[u] = (g / nn) * 64; tn0[u] = (g % nn) * 64; } else g -= cnt; } } } }
#pragma unroll
            for (int u = 0; u < 4; ++u) {
#pragma unroll
                for (int e = 0; e < 8; ++e) vals[u][e] = 0.f;
                if (tm[u] >= 0) { const int m = tm[u], n = tn0[u] + tx; const float* sp; int ld;
                    switch (m) {
                        case 0: sp = MapGU{P.in[I_F1G] + (size_t)l * DM * FF, P.in[I_F1U] + (size_t)l * DM * FF, FF}.ptr(n); ld = FF; break;
                        case 1: sp = P.in[I_F1D] + (size_t)l * FF * DM + n; ld = DM; break;
                        case 2: sp = MapWin{win, NCOL}.ptr(n); ld = NCOL; break;
                        case 3: sp = MapGate{win, NCOL}.ptr(n); ld = NCOL; break;
                        case 4: sp = P.in[I_PNSA] + (size_t)l * 256 * DM + n; ld = DM; break;
                        case 5: sp = P.in[I_PRET] + (size_t)l * 512 * DM + n; ld = DM; break;
                        case 6: sp = P.in[I_PRWKV] + (size_t)l * 256 * DM + n; ld = DM; break;
                        case 7: sp = P.in[I_PSWA] + (size_t)l * 256 * DM + n; ld = DM; break;
                        case 8: sp = P.in[I_WOUT] + (size_t)l * DM * DM + n; ld = DM; break;
                        case 9: sp = MapGU{P.in[I_F2G] + (size_t)l * DM * FF, P.in[I_F2U] + (size_t)l * DM * FF, FF}.ptr(n); ld = FF; break;
                        case 10: sp = P.in[I_F2D] + (size_t)l * FF * DM + n; ld = DM; break;
                        case 11: sp = P.in[I_CKW1] + (size_t)l * 2048 * 256 + n; ld = 256; break;
                        default: sp = P.in[I_CVW1] + (size_t)l * 2048 * 256 + n; ld = 256; break;
                    }
                    if (sp) {
#pragma unroll
                        for (int e = 0; e < 8; ++e) vals[u][e] = sp[(size_t)(tk0[u] + ty + 8 * e) * ld]; } } } };
        decode_load(bid);
        for (int g0 = bid; g0 < total; g0 += 4 * nb) {
            int ck0[4], cn0[4], cm[4];
#pragma unroll
            for (int u = 0; u < 4; ++u) { ck0[u] = tk0[u]; cn0[u] = tn0[u]; cm[u] = tm[u];
                if (tm[u] >= 0) { LAS float* tl = tile + u * 4160;
#pragma unroll
                    for (int e = 0; e < 8; ++e) tl[(ty + 8 * e) * 65 + tx] = vals[u][e]; } }
            __syncthreads();
            if (g0 + 4 * nb < total) decode_load(g0 + 4 * nb);
#pragma unroll
            for (int u = 0; u < 4; ++u) if (cm[u] >= 0) { const LAS float* sl = tile + u * 4160 + (8 * kc) * 65 + wn;
                u32x4 o; o.x = cvt_pk_bf16(sl[0], sl[65]); o.y = cvt_pk_bf16(sl[2 * 65], sl[3 * 65]); o.z = cvt_pk_bf16(sl[4 * 65], sl[5 * 65]); o.w = cvt_pk_bf16(sl[6 * 65], sl[7 * 65]);
                *(u32x4*)(W + mD[cm[u]] + (size_t)(cn0[u] + wn) * mK[cm[u]] + ck0[u] + 8 * kc) = o; }
            __syncthreads();
        }
    }
    if (bid < 64) {
        const int kv = bid >> 5, cidx = bid & 31, j = ctid & 255, half = ctid >> 8;
        const float* pos = P.in[kv ? I_POSV : I_POSK] + (size_t)l * 2048 + 64 * cidx + 32 * half; const float* w1 = P.in[kv ? I_CVW1 : I_CKW1] + (size_t)l * 2048 * 256 + (size_t)(64 * cidx + 32 * half) * 256 + j;
        float sacc = 0.f;
#pragma unroll 8
        for (int i = 0; i < 32; ++i) sacc += pos[i] * w1[(size_t)i * 256];
        __syncthreads();
        if (half) tile[j] = sacc;
        __syncthreads();
        if (!half) ((float*)(P.ws + WS_MISC + X_CBP))[(kv * 32 + cidx) * 256 + j] = sacc + tile[j];
        __syncthreads();
    }
    if (l == 0) {
        f32x2* rope = (f32x2*)(P.ws + WS_MISC + X_ROPE);
        for (int e = bid * 512 + ctid; e < S_ * 32; e += nb * 512) {
            const int pos = e >> 5, i = e & 31; const float invf = powf(10000.0f, -(float)i * 2.0f / 64.0f); const float ang = (float)pos * invf;
            double a = (double)ang; const double k = rint(a * 0.15915494309189535); a -= k * 6.283185307179586;
            const float af = (float)a; rope[e] = (f32x2){cosf(af), sinf(af)}; }
        bf16_t* kc = (bf16_t*)(P.ws + WS_Z3 + M_KCIN); bf16_t* vc = (bf16_t*)(P.ws + WS_Z3 + M_VCIN);
        for (int e = bid * 512 + ctid; e < 64 * 64; e += nb * 512) { kc[(size_t)T_ * 64 + e] = 0; vc[(size_t)T_ * 64 + e] = 0; }
    }
}

__device__ __forceinline__ void phase_rowpass(const float* xin, const bf16_t* F, const float* gpost, float coef, float* xout, const float* gpre, bf16_t* h, int bid, int nb, int wv__) {
    const int tid_ = opaque_tid(wv__), lane = tid_ & 63, gw = bid * 8 + (tid_ >> 6), NGW = nb * 8;
    f32x4 gpo[4], gpr[4];
#pragma unroll
    for (int j = 0; j < 4; ++j) { gpo[j] = F ? ((const f32x4*)gpost)[64 * j + lane] : (f32x4){0.f, 0.f, 0.f, 0.f}; gpr[j] = gpre ? ((const f32x4*)gpre)[64 * j + lane] : (f32x4){0.f, 0.f, 0.f, 0.f}; }
    f32x4 xn[4]; u32x2 fn[4];
    if (gw < T_) {
#pragma unroll
        for (int j = 0; j < 4; ++j) { xn[j] = ((const f32x4*)(xin + (size_t)gw * DM) + lane)[64 * j]; fn[j] = F ? ((const u32x2*)(F + (size_t)gw * DM) + lane)[64 * j] : (u32x2){0u, 0u}; } }
    for (int row = gw; row < T_; row += NGW) {
        f32x4 x[4]; u32x2 fw[4];
#pragma unroll
        for (int j = 0; j < 4; ++j) { x[j] = xn[j]; fw[j] = fn[j]; }
        const int nrow = row + NGW;
        if (nrow < T_) {
#pragma unroll
            for (int j = 0; j < 4; ++j) { xn[j] = ((const f32x4*)(xin + (size_t)nrow * DM) + lane)[64 * j]; fn[j] = F ? ((const u32x2*)(F + (size_t)nrow * DM) + lane)[64 * j] : (u32x2){0u, 0u}; } }
        if (F) {
            f32x4 f[4]; float s = 0.f;
#pragma unroll
            for (int j = 0; j < 4; ++j) { const u32x2 w = fw[j]; f[j] = (f32x4){bf_lo(w[0]), bf_hi(w[0]), bf_lo(w[1]), bf_hi(w[1])}; s += (f[j][0] * f[j][0] + f[j][1] * f[j][1]) + (f[j][2] * f[j][2] + f[j][3] * f[j][3]); }
            const float rs = coef * rsqrtf(wave_sum(s) * (1.0f / DM) + 1e-6f);
#pragma unroll
            for (int j = 0; j < 4; ++j) x[j] = x[j] + f[j] * gpo[j] * rs;
        }
        f32x4* xo = (f32x4*)(xout + (size_t)row * DM) + lane;
#pragma unroll
        for (int j = 0; j < 4; ++j) if (xout) xo[64 * j] = x[j];
        if (gpre) {
            float s = 0.f;
#pragma unroll
            for (int j = 0; j < 4; ++j) s += (x[j][0] * x[j][0] + x[j][1] * x[j][1]) + (x[j][2] * x[j][2] + x[j][3] * x[j][3]);
            const float rs = rsqrtf(wave_sum(s) * (1.0f / DM) + 1e-6f);
            u32x2* ho = (u32x2*)(h + (size_t)row * DM) + lane;
#pragma unroll
            for (int j = 0; j < 4; ++j) { const f32x4 v = x[j] * gpr[j] * rs; ho[64 * j] = (u32x2){cvt_pk_bf16(v[0], v[1]), cvt_pk_bf16(v[2], v[3])}; }
        }
    }
}

constexpr int A_KS = 0, A_VTS = 9216, A_MISC = 32768, A_BUF1 = 57344;
struct QF { bf16x8 f[4]; };
__device__ __forceinline__ bf16x8 pack8(const float* v) { u32x4 w = (u32x4){cvt_pk_bf16(v[0], v[1]), cvt_pk_bf16(v[2], v[3]), cvt_pk_bf16(v[4], v[5]), cvt_pk_bf16(v[6], v[7])}; return __builtin_bit_cast(bf16x8, w); }
__device__ __forceinline__ void load_q(QF& q, const bf16_t* qrow, int h, const f32x2* ropeRow, float scale) {
    float v[4][8];
#pragma unroll
    for (int ks = 0; ks < 4; ++ks) { const u32x4 w = *(const u32x4*)(qrow + 16 * ks + 8 * h);
        v[ks][0] = bf_lo(w.x); v[ks][1] = bf_hi(w.x); v[ks][2] = bf_lo(w.y); v[ks][3] = bf_hi(w.y); v[ks][4] = bf_lo(w.z); v[ks][5] = bf_hi(w.z); v[ks][6] = bf_lo(w.w); v[ks][7] = bf_hi(w.w); }
    if (ropeRow) {
#pragma unroll
        for (int ks = 0; ks < 2; ++ks)
#pragma unroll
            for (int j = 0; j < 8; ++j) { const f32x2 cs = ropeRow[16 * ks + 8 * h + j]; const float a = v[ks][j], b = v[ks + 2][j]; v[ks][j] = a * cs.x - b * cs.y; v[ks + 2][j] = b * cs.x + a * cs.y; }
    }
#pragma unroll
    for (int ks = 0; ks < 4; ++ks) {
#pragma unroll
        for (int j = 0; j < 8; ++j) v[ks][j] *= scale;
        q.f[ks] = pack8(v[ks]); }
}
__device__ __forceinline__ void qk_tile(const LAS unsigned char* Ks, const QF& q, int r, int h, f32x16 (&s)[2]) {
#pragma unroll
    for (int kt = 0; kt < 2; ++kt) { s[kt] = zero16();
#pragma unroll
        for (int ks = 0; ks < 4; ++ks) { const bf16x8 a = *(const LAS bf16x8*)(Ks + ((32 * kt + r) * 72 + 16 * ks + 8 * h) * 2); s[kt] = mfma32(a, q.f[ks], s[kt]); } }
}
__device__ __forceinline__ void pv_tile(const LAS unsigned char* Vts, int vrow0, const f32x16 (&p)[2], int r, int h, f32x16 (&o)[2]) {
#pragma unroll
    for (int kt = 0; kt < 2; ++kt)
#pragma unroll
        for (int s2 = 0; s2 < 2; ++s2) { float t[8];
#pragma unroll
            for (int j = 0; j < 8; ++j) t[j] = p[kt][8 * s2 + j];
            const bf16x8 pf = pack8(t);
#pragma unroll
            for (int dt = 0; dt < 2; ++dt) { const LAS unsigned char* ap = Vts + ((vrow0 + 32 * dt + r) * 68 + 32 * kt + 16 * s2 + 4 * h) * 2;
                const u32x2 lo = *(const LAS u32x2*)ap, hi = *(const LAS u32x2*)(ap + 16);
                const bf16x8 a = __builtin_bit_cast(bf16x8, (u32x4){lo.x, lo.y, hi.x, hi.y}); o[dt] = mfma32(a, pf, o[dt]); } }
}
template <bool FULL>
__device__ __forceinline__ void softmax_update(f32x16 (&s)[2], int lo, int hi, int h, float& m, float& l, f32x16 (&o)[2]) {
    float mx = m;
#pragma unroll
    for (int kt = 0; kt < 2; ++kt)
#pragma unroll
        for (int reg = 0; reg < 16; ++reg) {
            if (!FULL) { const int kl = 32 * kt + (reg & 3) + 8 * (reg >> 2) + 4 * h; const bool v = (kl >= lo) && (kl <= hi); s[kt][reg] = v ? s[kt][reg] : -INFINITY; }
            mx = fmaxf(mx, s[kt][reg]); }
    mx = fmaxf(mx, __shfl_xor(mx, 32));
    if (__any(mx > m)) {
        const float alpha = fast_exp2(m - mx); m = mx; l *= alpha;
#pragma unroll
        for (int dt = 0; dt < 2; ++dt) o[dt] = o[dt] * alpha;
    }
    float ls = 0.f;
#pragma unroll
    for (int kt = 0; kt < 2; ++kt)
#pragma unroll
        for (int reg = 0; reg < 16; ++reg) { const float p = fast_exp2(s[kt][reg] - mx); s[kt][reg] = p; ls += p; }
    l += ls;
}
__device__ __forceinline__ void store_kv_tile(LAS unsigned char* shm, u32x4 kreg, u32x4 vreg, int key, int c) {
    *(LAS u32x4*)(shm + A_KS + key * 144 + c * 16) = kreg;
    LAS bf16_t* vt = (LAS bf16_t*)(shm + A_VTS) + (8 * c) * 68 + key;
    vt[0] = (bf16_t)(vreg.x & 0xffff); vt[68] = (bf16_t)(vreg.x >> 16); vt[136] = (bf16_t)(vreg.y & 0xffff); vt[204] = (bf16_t)(vreg.y >> 16);
    vt[272] = (bf16_t)(vreg.z & 0xffff); vt[340] = (bf16_t)(vreg.z >> 16); vt[408] = (bf16_t)(vreg.w & 0xffff); vt[476] = (bf16_t)(vreg.w >> 16);
}
template <int MODE, class TR, class MK>
__device__ __forceinline__ void flash_loop(int ntiles, TR tileRow, MK maskAt, const bf16_t* Kg, const bf16_t* Vg, int ld, const QF& q, float& m, float& l, f32x16 (&o)[2],
                                           LAS unsigned char* shm, int tid, int lane, float inv = 0.f, LAS float* imp = nullptr, int qloc = 0) {
    if (ntiles <= 0) return;
    const int key = tid >> 3, c = tid & 7, r = lane & 31, h = lane >> 5;
    u32x4 kreg0, vreg0, kreg1 = (u32x4){0u, 0u, 0u, 0u}, vreg1 = (u32x4){0u, 0u, 0u, 0u};
    { const size_t off = (size_t)(tileRow(0) + key) * ld + 8 * c; kreg0 = *(const u32x4*)(Kg + off); vreg0 = *(const u32x4*)(Vg + off); }
    if (ntiles > 1) { const size_t off = (size_t)(tileRow(1) + key) * ld + 8 * c; kreg1 = *(const u32x4*)(Kg + off); vreg1 = *(const u32x4*)(Vg + off); }
    for (int i = 0; i < ntiles; i += 2) {
        __syncthreads();
        store_kv_tile(shm, kreg0, vreg0, key, c);
        if (i + 1 < ntiles) store_kv_tile(shm + A_BUF1, kreg1, vreg1, key, c);
        __syncthreads();
        if (i + 2 < ntiles) { const size_t off = (size_t)(tileRow(i + 2) + key) * ld + 8 * c; kreg0 = *(const u32x4*)(Kg + off); vreg0 = *(const u32x4*)(Vg + off); }
        if (i + 3 < ntiles) { const size_t off = (size_t)(tileRow(i + 3) + key) * ld + 8 * c; kreg1 = *(const u32x4*)(Kg + off); vreg1 = *(const u32x4*)(Vg + off); }
#pragma unroll 1
        for (int u = 0; u < 2; ++u) {
            const int ti = i + u; if (ti >= ntiles) break;
            LAS unsigned char* tb = shm + u * A_BUF1;
            int lo, hi; maskAt(ti, lo, hi);
            if (__all((hi < 0) || (lo > 63) || (hi < lo))) continue;
            const bool full = __all((lo <= 0) && (hi >= 63));
            f32x16 s[2]; qk_tile(tb + A_KS, q, r, h, s);
            if (MODE == 0) { if (full) softmax_update<true>(s, lo, hi, h, m, l, o); else softmax_update<false>(s, lo, hi, h, m, l, o); pv_tile(tb + A_VTS, 0, s, r, h, o); }
            else if (MODE == 1) { f32x16 dummy[2]; dummy[0] = zero16(); dummy[1] = zero16(); if (full) softmax_update<true>(s, lo, hi, h, m, l, dummy); else softmax_update<false>(s, lo, hi, h, m, l, dummy); }
            else {
#pragma unroll
                for (int kt = 0; kt < 2; ++kt)
#pragma unroll
                    for (int g = 0; g < 4; ++g) { float sum4 = 0.f, p3 = 0.f;
#pragma unroll
                        for (int e = 0; e < 4; ++e) { const int reg = 4 * g + e, kl = 32 * kt + 8 * g + 4 * h + e; const bool v = (kl >= lo) && (kl <= hi);
                            const float p = v ? fast_exp2(s[kt][reg] - m) * inv : 0.f; s[kt][reg] = p; sum4 += p; p3 = p; }
                        const int j = 16 * ti + 8 * kt + 2 * g + h;
                        __hip_atomic_fetch_add(imp + qloc * 65 + j, sum4, __ATOMIC_RELAXED, __HIP_MEMORY_SCOPE_WORKGROUP);
                        if (j + 1 < 64) __hip_atomic_fetch_add(imp + qloc * 65 + j + 1, p3, __ATOMIC_RELAXED, __HIP_MEMORY_SCOPE_WORKGROUP); }
                pv_tile(tb + A_VTS, 0, s, r, h, o);
            }
        }
    }
}

__device__ __forceinline__ void swa_item(const Params& P, int l, int it, LAS unsigned char* shm, int wv__) {
    const int tid = opaque_tid(wv__), lane = tid & 63, w = tid >> 6, r = lane & 31, h = lane >> 5;
    const int b = it >> 6, kvh = (it >> 5) & 1, qt = it & 31;
    const bf16_t* p = (const bf16_t*)(P.ws + WS_R1) + (size_t)b * S_ * LDP; const f32x2* rope = (const f32x2*)(P.ws + WS_MISC + X_ROPE);
    const int g = w >> 2, qsub = w & 3, head = 2 * kvh + g, qpos = 128 * qt + 32 * qsub + r;
    QF q; load_q(q, p + (size_t)qpos * LDP + C_SWAQ + 64 * head, h, rope + (size_t)qpos * 32, 0.125f * LOG2E);
    float m = P.in[I_SINK][l * 4 + head] * LOG2E, lsum = (h == 0) ? 1.f : 0.f; f32x16 o[2]; o[0] = zero16(); o[1] = zero16();
    const int j0 = (qt == 0) ? 0 : 2 * qt - 2, nt = 2 * qt + 2 - j0;
    flash_loop<0>(nt, [&](int i) { return 64 * (j0 + i); }, [&](int i, int& lo, int& hi) { const int tb = 64 * (j0 + i); lo = qpos - 127 - tb; hi = qpos - tb; },
                  p + C_SWAK + 64 * kvh, p + C_SWAV + 64 * kvh, LDP, q, m, lsum, o, shm, tid, lane);
    lsum += __shfl_xor(lsum, 32); const float inv = 1.0f / lsum;
    bf16_t* y = (bf16_t*)(P.ws + WS_Y + Y_SWA) + ((size_t)b * S_ + qpos) * 256 + 64 * head;
#pragma unroll
    for (int dt = 0; dt < 2; ++dt)
#pragma unroll
        for (int gg = 0; gg < 4; ++gg) { const f32x16& a = o[dt]; *(u32x2*)(y + 32 * dt + 8 * gg + 4 * h) = (u32x2){cvt_pk_bf16(a[4 * gg] * inv, a[4 * gg + 1] * inv), cvt_pk_bf16(a[4 * gg + 2] * inv, a[4 * gg + 3] * inv)}; }
}

__device__ __forceinline__ void nsa_cmp_item(const Params& P, int it, LAS unsigned char* shm, int wv__) {
    const int tid = opaque_tid(wv__), lane = tid & 63, w = tid >> 6, r = lane & 31, h = lane >> 5;
    const int b = it >> 6, qt = it & 63, q0 = 64 * qt;
    const bf16_t* p = (const bf16_t*)(P.ws + WS_R1) + (size_t)b * S_ * LDP;
    const bf16_t* kc = (const bf16_t*)(P.ws + WS_Z3 + M_KC) + (size_t)b * 256 * 64; const bf16_t* vc = (const bf16_t*)(P.ws + WS_Z3 + M_VC) + (size_t)b * 256 * 64;
    LAS float* imp = (LAS float*)(shm + A_MISC);
    for (int e = tid; e < 64 * 65; e += 512) imp[e] = 0.f;
    const int hd = w >> 1, qsub = w & 1, qloc = 32 * qsub + r, qpos = q0 + qloc;
    QF q; load_q(q, p + (size_t)qpos * LDP + C_NSAQ + 64 * hd, h, nullptr, 0.125f * LOG2E);
    const int nmax = (qpos - 31) >> 4, nml = (q0 + 63 - 31) >> 4, nt = nml < 0 ? 0 : (nml >> 6) + 1;
    float m = -1e30f, lsum = 0.f; f32x16 o[2]; o[0] = zero16(); o[1] = zero16();
    auto tr = [&](int i) { return 64 * i; }; auto mk = [&](int i, int& lo, int& hi) { lo = 0; hi = nmax - 64 * i; };
    flash_loop<1>(nt, tr, mk, kc, vc, 64, q, m, lsum, o, shm, tid, lane);
    lsum += __shfl_xor(lsum, 32); const float inv = lsum > 0.f ? 1.0f / lsum : 0.f;
    flash_loop<2>(nt, tr, mk, kc, vc, 64, q, m, lsum, o, shm, tid, lane, inv, imp, qloc);
    const float g0 = sigmoidf_(bf2f(p[(size_t)qpos * LDP + C_NGATE + hd * 3 + 0]));
    bf16_t* y = (bf16_t*)(P.ws + WS_Y + Y_NSA) + ((size_t)b * S_ + qpos) * 256 + 64 * hd;
#pragma unroll
    for (int dt = 0; dt < 2; ++dt)
#pragma unroll
        for (int gg = 0; gg < 4; ++gg) { const f32x16& a = o[dt]; *(u32x2*)(y + 32 * dt + 8 * gg + 4 * h) = (u32x2){cvt_pk_bf16(a[4 * gg] * g0, a[4 * gg + 1] * g0), cvt_pk_bf16(a[4 * gg + 2] * g0, a[4 * gg + 3] * g0)}; }
    __syncthreads();
    LAS float* scr = (LAS float*)(shm + A_MISC + 20480) + w * 64; unsigned long long* selm = (unsigned long long*)(P.ws + WS_Z3 + M_SEL) + (size_t)b * S_ + q0;
    const int cur = qt, j = lane;
    for (int qq = 8 * w; qq < 8 * w + 8; ++qq) {
        const bool forced = (j == 0) || (j == cur) || (j == cur - 1), valid = j <= cur;
        const float sc = forced ? 1e9f : (valid ? imp[qq * 65 + j] : -1e9f);
        scr[j] = sc; int rank = 0;
        for (int i = 0; i < 64; ++i) { const float si = scr[i]; rank += (si > sc || (si == sc && i < j)) ? 1 : 0; }
        const unsigned long long msk = __ballot(valid && rank < 16);
        if (lane == 0) selm[qq] = msk;
    }
    __syncthreads();
}

__device__ __forceinline__ void nsa_selwin_item(const Params& P, int it, LAS unsigned char* shm, int wv__) {
    const int tid = opaque_tid(wv__), lane = tid & 63, w = tid >> 6, r = lane & 31, h = lane >> 5;
    const int b = it & 7, qt = 63 - (it >> 3), q0 = 64 * qt;
    const bf16_t* p = (const bf16_t*)(P.ws + WS_R1) + (size_t)b * S_ * LDP; const f32x2* rope = (const f32x2*)(P.ws + WS_MISC + X_ROPE);
    const unsigned long long* selm = (const unsigned long long*)(P.ws + WS_Z3 + M_SEL) + (size_t)b * S_ + q0;
    const int hd = w >> 1, qsub = w & 1, qloc = 32 * qsub + r, qpos = q0 + qloc;
    LAS int* list = (LAS int*)(shm + A_MISC);
    unsigned long long un = selm[lane];
#pragma unroll
    for (int off = 1; off < 64; off <<= 1) { const unsigned lo = __shfl_xor((unsigned)un, off), hi = __shfl_xor((unsigned)(un >> 32), off); un |= ((unsigned long long)hi << 32) | lo; }
    const int nsel = __popcll(un);
    __syncthreads();
    if (tid == 0) { unsigned long long u = un; int k = 0; while (u) { list[k++] = __ffsll((long long)u) - 1; u &= u - 1; } }
    __syncthreads();
    const unsigned long long mysel = selm[qloc];
    QF q; load_q(q, p + (size_t)qpos * LDP + C_NSAQ + 64 * hd, h, rope + (size_t)qpos * 32, 0.125f * LOG2E);
    const float g1 = sigmoidf_(bf2f(p[(size_t)qpos * LDP + C_NGATE + hd * 3 + 1])), g2 = sigmoidf_(bf2f(p[(size_t)qpos * LDP + C_NGATE + hd * 3 + 2]));
    bf16_t* y = (bf16_t*)(P.ws + WS_Y + Y_NSA) + ((size_t)b * S_ + qpos) * 256 + 64 * hd;
    auto accum = [&](const f32x16 (&o)[2], float inv) {
#pragma unroll
        for (int dt = 0; dt < 2; ++dt)
#pragma unroll
            for (int gg = 0; gg < 4; ++gg) { u32x2* yp = (u32x2*)(y + 32 * dt + 8 * gg + 4 * h); const u32x2 c = *yp; const f32x16& a = o[dt];
                *yp = (u32x2){cvt_pk_bf16(a[4 * gg] * inv + bf_lo(c.x), a[4 * gg + 1] * inv + bf_hi(c.x)), cvt_pk_bf16(a[4 * gg + 2] * inv + bf_lo(c.y), a[4 * gg + 3] * inv + bf_hi(c.y))}; } };
    {
        float m = -1e30f, lsum = 0.f; f32x16 o[2]; o[0] = zero16(); o[1] = zero16();
        flash_loop<0>(nsel, [&](int i) { return 64 * list[i]; },
                      [&](int i, int& lo, int& hi) { const int j = list[i]; lo = 0; hi = ((mysel >> j) & 1ull) ? (qpos - 64 * j) : -1; },
                      p + C_KSLC, p + C_VSLC, LDP, q, m, lsum, o, shm, tid, lane);
        lsum += __shfl_xor(lsum, 32); accum(o, lsum > 0.f ? g1 / lsum : 0.f);
    }
    {
        float m = -1e30f, lsum = 0.f; f32x16 o[2]; o[0] = zero16(); o[1] = zero16();
        const int j0 = qt >= 8 ? qt - 8 : 0, nt = qt - j0 + 1;
        flash_loop<0>(nt, [&](int i) { return 64 * (j0 + i); }, [&](int i, int& lo, int& hi) { const int tb = 64 * (j0 + i); lo = qpos - 511 - tb; hi = qpos - tb; },
                      p + C_KWIN, p + C_VWIN, LDP, q, m, lsum, o, shm, tid, lane);
        lsum += __shfl_xor(lsum, 32); accum(o, g2 / lsum);
    }
    __syncthreads();
}

__device__ __forceinline__ float ret_log2g(int hd) { return log2f(1.0f - exp2f(-5.0f - (float)hd)); }
__device__ __forceinline__ void ret_kv_item(const Params& P, int it, LAS unsigned char* shm, int wv__) {
    const int tid = opaque_tid(wv__), lane = tid & 63, w = tid >> 6, r = lane & 31, h = lane >> 5;
    const int n = it & 31, hd = (it >> 5) & 3, b = it >> 7;
    const bf16_t* p = (const bf16_t*)(P.ws + WS_R1) + ((size_t)b * S_ + 128 * n) * LDP;
    LAS bf16_t* Kt = (LAS bf16_t*)shm; LAS bf16_t* Vt = (LAS bf16_t*)(shm + 17408);
    const float l2g = ret_log2g(hd);
    __syncthreads();
#pragma unroll
    for (int i = 0; i < 2; ++i) { const int task = tid + 512 * i, tok = task >> 3, c = task & 7; const u32x4 wv = *(const u32x4*)(p + (size_t)tok * LDP + C_RETK + 64 * hd + 8 * c);
        const float z = fast_exp2(l2g * (float)(127 - tok)); const unsigned ww[4] = {wv.x, wv.y, wv.z, wv.w}; LAS bf16_t* kt = Kt + (8 * c) * 136 + tok;
#pragma unroll
        for (int e = 0; e < 4; ++e) { const unsigned pk = cvt_pk_bf16(bf_lo(ww[e]) * z, bf_hi(ww[e]) * z); kt[(2 * e) * 136] = (bf16_t)(pk & 0xffff); kt[(2 * e + 1) * 136] = (bf16_t)(pk >> 16); } }
#pragma unroll
    for (int i = 0; i < 4; ++i) { const int task = tid + 512 * i, tok = task >> 4, c = task & 15; const u32x4 wv = *(const u32x4*)(p + (size_t)tok * LDP + C_RETV + 128 * hd + 8 * c);
        const unsigned ww[4] = {wv.x, wv.y, wv.z, wv.w}; LAS bf16_t* vt = Vt + (8 * c) * 136 + tok;
#pragma unroll
        for (int e = 0; e < 4; ++e) { vt[(2 * e) * 136] = (bf16_t)(ww[e] & 0xffff); vt[(2 * e + 1) * 136] = (bf16_t)(ww[e] >> 16); } }
    __syncthreads();
    const int et = w >> 1, dtile = w & 1; f32x16 acc = zero16();
#pragma unroll
    for (int s = 0; s < 8; ++s) { const bf16x8 a = *(const LAS bf16x8*)(Vt + (32 * et + r) * 136 + 16 * s + 8 * h), bb = *(const LAS bf16x8*)(Kt + (32 * dtile + r) * 136 + 16 * s + 8 * h); acc = mfma32(a, bb, acc); }
    bf16_t* kv = (bf16_t*)(P.ws + WS_Z3 + M_KV) + (size_t)it * 8192;
#pragma unroll
    for (int reg = 0; reg < 16; ++reg) { const int e = 32 * et + (reg & 3) + 8 * (reg >> 2) + 4 * h; kv[e * 64 + 32 * dtile + r] = (bf16_t)(cvt_pk_bf16(acc[reg], 0.f) & 0xffff); }
}

__device__ __forceinline__ void ret_out_item(const Params& P, int l, int it, LAS unsigned char* shm, int wv__) {
    const int tid = opaque_tid(wv__), lane = tid & 63, w = tid >> 6, r = lane & 31, h = lane >> 5;
    const int n = it & 31, hd = (it >> 5) & 3, b = it >> 7;
    const bf16_t* p = (const bf16_t*)(P.ws + WS_R1) + ((size_t)b * S_ + 128 * n) * LDP; const f32x2* rope = (const f32x2*)(P.ws + WS_MISC + X_ROPE);
    LAS bf16_t* Rt = (LAS bf16_t*)(shm + A_MISC); LAS f32x2* part = (LAS f32x2*)(shm + A_MISC + 18432);
    const float l2g = ret_log2g(hd), gch = fast_exp2(l2g * 128.0f);
    const int key = tid >> 3, c = tid & 7;
    u32x4 tk[2], tv0[2], tv1[2];
#pragma unroll
    for (int kt2 = 0; kt2 < 2; ++kt2) { const size_t off = (size_t)(64 * kt2 + key) * LDP;
        tk[kt2] = *(const u32x4*)(p + off + C_RETK + 64 * hd + 8 * c); tv0[kt2] = *(const u32x4*)(p + off + C_RETV + 128 * hd + 8 * c); tv1[kt2] = *(const u32x4*)(p + off + C_RETV + 128 * hd + 64 + 8 * c); }
    __syncthreads();
    {
        const bf16_t* kv = (const bf16_t*)(P.ws + WS_Z3 + M_KV) + (size_t)(it - n) * 8192 + tid * 16; f32x4 a[4];
#pragma unroll
        for (int i = 0; i < 4; ++i) a[i] = (f32x4){0.f, 0.f, 0.f, 0.f};
#pragma unroll 8
        for (int j = 0; j < n; ++j) { const u32x4* s = (const u32x4*)(kv + (size_t)j * 8192); const u32x4 s0 = s[0], s1 = s[1];
            a[0] = a[0] * gch + (f32x4){bf_lo(s0.x), bf_hi(s0.x), bf_lo(s0.y), bf_hi(s0.y)}; a[1] = a[1] * gch + (f32x4){bf_lo(s0.z), bf_hi(s0.z), bf_lo(s0.w), bf_hi(s0.w)};
            a[2] = a[2] * gch + (f32x4){bf_lo(s1.x), bf_hi(s1.x), bf_lo(s1.y), bf_hi(s1.y)}; a[3] = a[3] * gch + (f32x4){bf_lo(s1.z), bf_hi(s1.z), bf_lo(s1.w), bf_hi(s1.w)}; }
        const int e = tid >> 2, d0 = (tid & 3) * 16; LAS u32x4* dst = (LAS u32x4*)(Rt + e * 72 + d0);
        dst[0] = (u32x4){cvt_pk_bf16(a[0][0], a[0][1]), cvt_pk_bf16(a[0][2], a[0][3]), cvt_pk_bf16(a[1][0], a[1][1]), cvt_pk_bf16(a[1][2], a[1][3])};
        dst[1] = (u32x4){cvt_pk_bf16(a[2][0], a[2][1]), cvt_pk_bf16(a[2][2], a[2][3]), cvt_pk_bf16(a[3][0], a[3][1]), cvt_pk_bf16(a[3][2], a[3][3])};
    }
    const int qsub = w & 3, eh = w >> 2, qc = 32 * qsub + r, qpos = 128 * n + qc;
    QF q; load_q(q, p + (size_t)qc * LDP + C_RETQ + 64 * hd, h, rope + (size_t)qpos * 32, 0.125f);
    __syncthreads();
    f32x16 o[2];
#pragma unroll
    for (int dt = 0; dt < 2; ++dt) { o[dt] = zero16();
#pragma unroll
        for (int ks = 0; ks < 4; ++ks) { const bf16x8 a = *(const LAS bf16x8*)(Rt + (64 * eh + 32 * dt + r) * 72 + 16 * ks + 8 * h); o[dt] = mfma32(a, q.f[ks], o[dt]); }
        o[dt] = o[dt] * fast_exp2(l2g * (float)(qc + 1)); }
#pragma unroll
    for (int kt2 = 0; kt2 < 2; ++kt2) {
        const u32x4 kreg = tk[kt2], v0 = tv0[kt2], v1 = tv1[kt2];
        __syncthreads();
        store_kv_tile(shm, kreg, v0, key, c);
        { LAS bf16_t* vt = (LAS bf16_t*)(shm + A_VTS) + (64 + 8 * c) * 68 + key;
          vt[0] = (bf16_t)(v1.x & 0xffff); vt[68] = (bf16_t)(v1.x >> 16); vt[136] = (bf16_t)(v1.y & 0xffff); vt[204] = (bf16_t)(v1.y >> 16);
          vt[272] = (bf16_t)(v1.z & 0xffff); vt[340] = (bf16_t)(v1.z >> 16); vt[408] = (bf16_t)(v1.w & 0xffff); vt[476] = (bf16_t)(v1.w >> 16); }
        __syncthreads();
        if (64 * kt2 <= 32 * qsub + 31) {
            f32x16 s[2]; qk_tile(shm + A_KS, q, r, h, s);
#pragma unroll
            for (int kt = 0; kt < 2; ++kt)
#pragma unroll
                for (int reg = 0; reg < 16; ++reg) { const int kc_ = 64 * kt2 + 32 * kt + (reg & 3) + 8 * (reg >> 2) + 4 * h, diff = qc - kc_;
                    s[kt][reg] = diff >= 0 ? s[kt][reg] * fast_exp2(l2g * (float)diff) : 0.f; }
            pv_tile(shm + A_VTS, 64 * eh, s, r, h, o);
        }
    }
    float s1 = 0.f, s2 = 0.f;
#pragma unroll
    for (int dt = 0; dt < 2; ++dt)
#pragma unroll
        for (int e = 0; e < 16; ++e) { s1 += o[dt][e]; s2 += o[dt][e] * o[dt][e]; }
    s1 += __shfl_xor(s1, 32); s2 += __shfl_xor(s2, 32);
    if (h == 0) part[eh * 128 + qc] = (f32x2){s1, s2};
    __syncthreads();
    const f32x2 pa = part[qc], pb = part[128 + qc];
    const float mean = (pa.x + pb.x) * (1.0f / 128.0f), var = (pa.y + pb.y) * (1.0f / 128.0f) - mean * mean, rstd = rsqrtf(fmaxf(var, 0.f) + 1e-5f);
    const float* gn = P.in[I_GNG] + (size_t)l * 512 + 128 * hd;
    bf16_t* y = (bf16_t*)(P.ws + WS_Y + Y_RET) + ((size_t)b * S_ + qpos) * 512 + 128 * hd;
    const bf16_t* gin = p + (size_t)qc * LDP + C_RETG + 128 * hd;
#pragma unroll
    for (int dt = 0; dt < 2; ++dt)
#pragma unroll
        for (int gg = 0; gg < 4; ++gg) { const int e = 64 * eh + 32 * dt + 8 * gg + 4 * h; const f32x4 g4 = *(const f32x4*)(gn + e); const u32x2 gi = *(const u32x2*)(gin + e);
            const float gv[4] = {bf_lo(gi.x), bf_hi(gi.x), bf_lo(gi.y), bf_hi(gi.y)}; float ov[4];
#pragma unroll
            for (int i = 0; i < 4; ++i) { const float on = (o[dt][4 * gg + i] - mean) * rstd * g4[i]; ov[i] = gv[i] * sigmoidf_(gv[i]) * on; }
            *(u32x2*)(y + e) = (u32x2){cvt_pk_bf16(ov[0], ov[1]), cvt_pk_bf16(ov[2], ov[3])}; }
    __syncthreads();
}

template <int CTRL> __device__ __forceinline__ float dpp_add(float x) { return x + __builtin_bit_cast(float, __builtin_amdgcn_update_dpp(0, __builtin_bit_cast(int, x), CTRL, 0xf, 0xf, true)); }
__device__ __forceinline__ float reduce8(float x) { x = dpp_add<0xB1>(x); x = dpp_add<0x4E>(x); x = dpp_add<0x141>(x); return x; }
__device__ __forceinline__ float reduce16(float x) { x = reduce8(x); x = dpp_add<0x140>(x); return x; }
constexpr int R_R = 0, R_K = 8192, R_W = 16384, R_KK = 24576, R_KKA = 32768, R_A = 40960, R_VP = 49152, R_GP = 53248, R_YP = 57344, R_RK = 61440, R_ST = 61696,
              R_TW = 62720, R_AL = 67328, R_GL = 71936, R_W2 = 80640, R_A2 = 89856, R_G2 = 99072, R_END = 107776, R_V3X = 107776, R_RK2X = 113920;
__device__ __forceinline__ void rwkv_item(const Params& P, int l, int it, LAS unsigned char* shm, int wv__) {
    const int tid = opaque_tid(wv__), lane = tid & 63, w = tid >> 6, r = lane & 31, h = lane >> 5;
    const int chain = it >> 2, part = it & 3, b = chain >> 2, hd = chain & 3;
    const bf16_t* p = (const bf16_t*)(P.ws + WS_R1) + (size_t)b * S_ * LDP + C_RWKV;
    const float* mu = P.in[I_MU] + (size_t)l * 1024;
    LAS float* sR = (LAS float*)(shm + R_R); LAS float* sK = (LAS float*)(shm + R_K); LAS float* sW = (LAS float*)(shm + R_W);
    LAS float* sA = (LAS float*)(shm + R_A); LAS float* sKK = (LAS float*)(shm + R_KK); LAS float* sKKA = (LAS float*)(shm + R_KKA);
    LAS float* sVp = (LAS float*)(shm + R_VP); LAS float* sGp = (LAS float*)(shm + R_GP); LAS float* sYp = (LAS float*)(shm + R_YP);
    LAS float* sRK = (LAS float*)(shm + R_RK); LAS float* sST = (LAS float*)(shm + R_ST);
    LAS bf16_t* sTW = (LAS bf16_t*)(shm + R_TW); LAS bf16_t* sAL = (LAS bf16_t*)(shm + R_AL); LAS bf16_t* sGL = (LAS bf16_t*)(shm + R_GL);
    LAS bf16_t* W2t = (LAS bf16_t*)(shm + R_W2); LAS bf16_t* A2t = (LAS bf16_t*)(shm + R_A2); LAS bf16_t* G2t = (LAS bf16_t*)(shm + R_G2);
    __syncthreads();
    {
        const float* w2 = P.in[I_W2] + (size_t)l * 64 * 256 + 64 * hd; const float* a2 = P.in[I_A2] + (size_t)l * 64 * 256 + 64 * hd; const float* g2 = P.in[I_G2] + (size_t)l * 128 * 256 + 64 * hd + 16 * part;
        for (int e = tid; e < 4096; e += 512) { const int k = e >> 6, n = e & 63; W2t[n * 72 + k] = (bf16_t)(cvt_pk_bf16(w2[k * 256 + n], 0.f) & 0xffff); A2t[n * 72 + k] = (bf16_t)(cvt_pk_bf16(a2[k * 256 + n], 0.f) & 0xffff); }
        for (int e = tid; e < 4096; e += 512) { const int k = e >> 5, n = e & 31; G2t[n * 136 + k] = n < 16 ? (bf16_t)(cvt_pk_bf16(g2[k * 256 + n], 0.f) & 0xffff) : (bf16_t)0; }
    }
    const int t4 = tid & 255;
    int tcol[13], ttok[13];
#pragma unroll
    for (int i = 0; i < 8; ++i) { ttok[i] = (t4 >> 4) + 16 * (i & 1); tcol[i] = (i < 2 ? 64 * hd : i < 4 ? 256 + 64 * hd : i < 6 ? 768 : 832) + 4 * (t4 & 15); }
#pragma unroll
    for (int i = 8; i < 12; ++i) { ttok[i] = (t4 >> 5) + 8 * (i - 8); tcol[i] = 896 + 4 * (t4 & 31); }
    ttok[12] = t4 < 128 ? (t4 >> 2) : -1; tcol[12] = 512 + 64 * hd + 16 * part + 4 * (t4 & 3);
    u32x2 cur[13], prv[13];
    auto issue = [&](int ch) {
#pragma unroll
        for (int i = 0; i < 13; ++i) { const int t = 32 * ch + ttok[i]; cur[i] = (u32x2){0u, 0u}; prv[i] = (u32x2){0u, 0u};
            if (ttok[i] >= 0) { cur[i] = *(const u32x2*)(p + (size_t)t * LDP + tcol[i]); if (t > 0) prv[i] = *(const u32x2*)(p + (size_t)(t - 1) * LDP + tcol[i]); } } };
    LAS float* sR2 = (LAS float*)(shm + R_RK2X); LAS float* sK2 = sR2 + 2048; LAS float* sV3 = (LAS float*)(shm + R_V3X);
    auto stage_a = [&](int ch) {
        LAS float* dR = (ch & 1) ? sR2 : sR; LAS float* dK = (ch & 1) ? sK2 : sK; LAS float* dV = sV3 + (ch % 3) * 512;
#pragma unroll
        for (int i = 0; i < 13; ++i) if (ttok[i] >= 0) { const int tt = ttok[i], col = tcol[i]; const f32x4 m4 = *(const f32x4*)(mu + col);
            const float c0 = bf_lo(cur[i].x), c1 = bf_hi(cur[i].x), c2 = bf_lo(cur[i].y), c3 = bf_hi(cur[i].y);
            const float x0 = c0 + m4[0] * (bf_lo(prv[i].x) - c0), x1 = c1 + m4[1] * (bf_hi(prv[i].x) - c1), x2 = c2 + m4[2] * (bf_lo(prv[i].y) - c2), x3 = c3 + m4[3] * (bf_hi(prv[i].y) - c3);
            if (i < 2) *(LAS f32x4*)(dR + tt * 64 + (col & 63)) = (f32x4){x0, x1, x2, x3};
            else if (i < 4) *(LAS f32x4*)(dK + tt * 64 + (col & 63)) = (f32x4){x0, x1, x2, x3};
            else if (i == 12) *(LAS f32x4*)(dV + tt * 16 + (col & 15)) = (f32x4){x0, x1, x2, x3};
            else if (i < 6) *(LAS u32x2*)(sTW + tt * 72 + (col - 768)) = (u32x2){cvt_pk_bf16(fast_tanh(x0), fast_tanh(x1)), cvt_pk_bf16(fast_tanh(x2), fast_tanh(x3))};
            else if (i < 8) *(LAS u32x2*)(sAL + tt * 72 + (col - 832)) = (u32x2){cvt_pk_bf16(x0, x1), cvt_pk_bf16(x2, x3)};
            else *(LAS u32x2*)(sGL + tt * 136 + (col - 896)) = (u32x2){cvt_pk_bf16(fast_sigmoid(x0), fast_sigmoid(x1)), cvt_pk_bf16(fast_sigmoid(x2), fast_sigmoid(x3))}; } };
    const float w0v = P.in[I_W0][(size_t)l * 256 + 64 * hd + 32 * (w & 1) + r], a0v = P.in[I_A0][(size_t)l * 256 + 64 * hd + 32 * (w & 1) + r];
    f32x2 st01 = (f32x2){0.f, 0.f}, st23 = (f32x2){0.f, 0.f};
    const int srow = 4 * w + (lane >> 4), scg = lane & 15;
    const int ptok = tid >> 4, pl = tid & 15, pc = pl * 4, hc = 64 * hd + pc;
    const f32x4 kk4 = *(const f32x4*)(P.in[I_KK] + (size_t)l * 256 + hc), ka4 = *(const f32x4*)(P.in[I_KA] + (size_t)l * 256 + hc), rk4 = *(const f32x4*)(P.in[I_RK] + (size_t)l * 256 + hc);
    const int och = 64 * hd + 16 * part + pl;
    const float lng = P.in[I_LNG][(size_t)l * 256 + och], lnb = P.in[I_LNB][(size_t)l * 256 + och];
    bf16_t* yout = (bf16_t*)(P.ws + WS_Y + Y_RWKV) + (size_t)b * S_ * 256 + och; bf16_t* a1out = (bf16_t*)(P.ws + WS_Z3 + M_A1) + (size_t)b * S_ * 256 + och; bf16_t* a2out = (bf16_t*)(P.ws + WS_Z3 + M_A2) + (size_t)b * S_ * 256 + och;
    auto stage_b = [&](int ch) {
        if (w < 5) { const int mat = w >> 1, ntile = w & 1; f32x16 c = zero16(); const int chn = 32 * ntile + r;
            if (mat == 0) {
#pragma unroll
                for (int ks = 0; ks < 4; ++ks) c = mfma32(*(const LAS bf16x8*)(sTW + r * 72 + 16 * ks + 8 * h), *(const LAS bf16x8*)(W2t + chn * 72 + 16 * ks + 8 * h), c);
#pragma unroll
                for (int reg = 0; reg < 16; ++reg) { const int tok = (reg & 3) + 8 * (reg >> 2) + 4 * h; sW[tok * 64 + chn] = w0v + c[reg]; }
            } else if (mat == 1) {
#pragma unroll
                for (int ks = 0; ks < 4; ++ks) c = mfma32(*(const LAS bf16x8*)(sAL + r * 72 + 16 * ks + 8 * h), *(const LAS bf16x8*)(A2t + chn * 72 + 16 * ks + 8 * h), c);
#pragma unroll
                for (int reg = 0; reg < 16; ++reg) { const int tok = (reg & 3) + 8 * (reg >> 2) + 4 * h; sA[tok * 64 + chn] = a0v + c[reg]; }
            } else {
#pragma unroll
                for (int ks = 0; ks < 8; ++ks) c = mfma32(*(const LAS bf16x8*)(sGL + r * 136 + 16 * ks + 8 * h), *(const LAS bf16x8*)(G2t + r * 136 + 16 * ks + 8 * h), c);
                if (r < 16) {
#pragma unroll
                    for (int reg = 0; reg < 16; ++reg) { const int tok = (reg & 3) + 8 * (reg >> 2) + 4 * h; sGp[(ch & 1) * 512 + tok * 16 + r] = c[reg]; } }
            } } };
    auto stage_c = [&](int ch) {
        LAS float* bR = (ch & 1) ? sR2 : sR; LAS float* bK = (ch & 1) ? sK2 : sK;
        const f32x4 k = *(const LAS f32x4*)(bK + ptok * 64 + pc), araw = *(const LAS f32x4*)(sA + ptok * 64 + pc), wraw = *(const LAS f32x4*)(sW + ptok * 64 + pc), rr = *(const LAS f32x4*)(bR + ptok * 64 + pc);
        f32x4 a, dec;
#pragma unroll
        for (int e = 0; e < 4; ++e) { a[e] = fast_sigmoid(araw[e]); dec[e] = __expf(-0.6065306597126334f * fast_sigmoid(wraw[e])); }
        *(LAS f32x4*)(sW + ptok * 64 + pc) = dec;
        const f32x4 kkv = k * kk4; float ss = (kkv[0] * kkv[0] + kkv[1] * kkv[1]) + (kkv[2] * kkv[2] + kkv[3] * kkv[3]); ss = reduce16(ss);
        const float inv = __builtin_amdgcn_rcpf(fmaxf(sqrtf(ss), 1e-12f)); const f32x4 kk = kkv * inv; const f32x4 kp = k * (1.0f + (a - 1.0f) * ka4);
        float rk = (rr[0] * kp[0] * rk4[0] + rr[1] * kp[1] * rk4[1]) + (rr[2] * kp[2] * rk4[2] + rr[3] * kp[3] * rk4[3]); rk = reduce16(rk);
        *(LAS f32x4*)(sKK + ptok * 64 + pc) = kk; *(LAS f32x4*)(sKKA + ptok * 64 + pc) = kk * a; *(LAS f32x4*)(bK + ptok * 64 + pc) = kp;
        if (pl == 0) sRK[(ch & 1) * 32 + ptok] = rk; };
    auto stage_e = [&](int ch) {
#pragma unroll
        for (int i = 0; i < 2; ++i) { const int tk = (t4 >> 4) + 16 * i, q = (t4 & 15);
            const float y = sYp[(ch & 1) * 512 + tk * 16 + q], vv = sV3[(ch % 3) * 512 + tk * 16 + q], g = sGp[(ch & 1) * 512 + tk * 16 + q], rk = sRK[(ch & 1) * 32 + tk]; const size_t o = (size_t)(32 * ch + tk) * 256;
            yout[o] = (bf16_t)(cvt_pk_bf16(y, 0.f) & 0xffff); a1out[o] = (bf16_t)(cvt_pk_bf16(lng * g, 0.f) & 0xffff); a2out[o] = (bf16_t)(cvt_pk_bf16((lnb + rk * vv) * g, 0.f) & 0xffff); } };
    const int NCH = S_ / 32;
    if (w >= 4) { issue(0); stage_a(0); issue(1); }
    __syncthreads();
    stage_b(0); __syncthreads(); stage_c(0); __syncthreads();
    for (int ch = 0; ch < NCH; ++ch) {
        if (w < 4) {
            const LAS float* cK = (ch & 1) ? sK2 : sK; const LAS float* cR = (ch & 1) ? sR2 : sR;
            const LAS float* bw = sW + 4 * scg; const LAS float* bk = sKK + 4 * scg; const LAS float* ba = sKKA + 4 * scg; const LAS float* bp = cK + 4 * scg; const LAS float* br = cR + 4 * scg;
            const LAS float* bv = sV3 + (ch % 3) * 512 + srow; LAS float* by = sYp + (ch & 1) * 512 + srow;
            f32x4 nw = *(const LAS f32x4*)bw, nk = *(const LAS f32x4*)bk, na = *(const LAS f32x4*)ba, np = *(const LAS f32x4*)bp, nr = *(const LAS f32x4*)br; float nv = bv[0];
#pragma unroll 4
            for (int tt = 0; tt < 32; ++tt) {
                const f32x4 w4 = nw, k4 = nk, a4 = na, p4 = np, r4 = nr; const float v = nv;
                if (tt + 1 < 32) { const int o = (tt + 1) * 64; nw = *(const LAS f32x4*)(bw + o); nk = *(const LAS f32x4*)(bk + o); na = *(const LAS f32x4*)(ba + o); np = *(const LAS f32x4*)(bp + o); nr = *(const LAS f32x4*)(br + o); nv = bv[(tt + 1) * 16]; }
                f32x2 d = st01 * (f32x2){k4[0], k4[1]}; d = st23 * (f32x2){k4[2], k4[3]} + d;
                f32x2 u01 = st01 * (f32x2){w4[0], w4[1]} + (f32x2){p4[0], p4[1]} * v, u23 = st23 * (f32x2){w4[2], w4[3]} + (f32x2){p4[2], p4[3]} * v;
                const float sa = -reduce16(d.x + d.y);
                st01 = (f32x2){a4[0], a4[1]} * sa + u01; st23 = (f32x2){a4[2], a4[3]} * sa + u23;
                f32x2 yy = st01 * (f32x2){r4[0], r4[1]}; yy = st23 * (f32x2){r4[2], r4[3]} + yy;
                const float y = reduce16(yy.x + yy.y);
                if (scg == 0) by[tt * 16] = y;
            }
        } else {
            if (ch >= 1) stage_e(ch - 1);
            if (ch + 1 < NCH) { stage_a(ch + 1); if (ch + 2 < NCH) issue(ch + 2); }
        }
        __syncthreads();
        if (ch + 1 < NCH) { stage_b(ch + 1); __syncthreads(); stage_c(ch + 1); __syncthreads(); }
    }
    if (w >= 4) stage_e(NCH - 1);
    __syncthreads();
}

constexpr int LDS_BYTES = 147456, L_ITEM = 140000;
__device__ __forceinline__ void phase_cmp2(const Params& P, int l, int bid, int nb, int wv__) {
    const int ctid = opaque_tid(wv__);
    for (int o = bid * 512 + ctid; o < 2 * 2048 * 64; o += nb * 512) {
        const int kv = o >> 17, m = (o >> 6) & 2047, j = o & 63;
        const bf16_t* hrow = (const bf16_t*)(P.ws + WS_Z3 + (kv ? M_H1V : M_H1K)) + (size_t)m * 256;
        const float* w2 = P.in[kv ? I_CVW2 : I_CKW2] + (size_t)l * 256 * 64 + j; float s = 0.f;
#pragma unroll 4
        for (int i = 0; i < 256; i += 8) { const u32x4 hv = *(const u32x4*)(hrow + i); const unsigned ww[4] = {hv.x, hv.y, hv.z, hv.w};
#pragma unroll
            for (int e = 0; e < 4; ++e) { s += bf_lo(ww[e]) * w2[(size_t)(i + 2 * e) * 64]; s += bf_hi(ww[e]) * w2[(size_t)(i + 2 * e + 1) * 64]; } }
        ((bf16_t*)(P.ws + WS_Z3 + (kv ? M_VC : M_KC)))[(size_t)m * 64 + j] = (bf16_t)(cvt_pk_bf16(s, 0.f) & 0xffff);
    }
}


#ifdef PROF_SEL
#define STAMP(cat) do { if (bid == 0 && opaque_tid(wv__) == 0) { const long long now_ = wall_clock64(); LAS long long* pa_ = (LAS long long*)(shm + 141000); pa_[cat] += now_ - pa_[7]; pa_[7] = now_; } } while (0)
#else
#define STAMP(cat) do {} while (0)
#endif
__device__ __forceinline__ void phase_rwkv_ln(const Params& P, int bid, int nb, int wv__) {
    const int tid = opaque_tid(wv__);
    bf16_t* y = (bf16_t*)(P.ws + WS_Y + Y_RWKV); const bf16_t* a1 = (const bf16_t*)(P.ws + WS_Z3 + M_A1); const bf16_t* a2 = (const bf16_t*)(P.ws + WS_Z3 + M_A2);
    const int gs = nb * 512; int g = bid * 512 + tid;
    u32x2 nyw = (u32x2){0u, 0u}, np1 = nyw, np2 = nyw;
    if (g < T_ * 64) { const size_t o = (size_t)g * 4; nyw = *(const u32x2*)(y + o); np1 = *(const u32x2*)(a1 + o); np2 = *(const u32x2*)(a2 + o); }
    for (; g < T_ * 64; g += gs) {
        const size_t o = (size_t)g * 4; const u32x2 yw = nyw, p1 = np1, p2 = np2;
        if (g + gs < T_ * 64) { const size_t on = (size_t)(g + gs) * 4; nyw = *(const u32x2*)(y + on); np1 = *(const u32x2*)(a1 + on); np2 = *(const u32x2*)(a2 + on); }
        const float y0 = bf_lo(yw.x), y1 = bf_hi(yw.x), y2 = bf_lo(yw.y), y3 = bf_hi(yw.y);
        const float mean = reduce16((y0 + y1) + (y2 + y3)) * (1.0f / 64.0f); const float d0 = y0 - mean, d1 = y1 - mean, d2 = y2 - mean, d3 = y3 - mean;
        const float rstd = rsqrtf(reduce16((d0 * d0 + d1 * d1) + (d2 * d2 + d3 * d3)) * (1.0f / 64.0f) + 64e-5f);
        *(u32x2*)(y + o) = (u32x2){cvt_pk_bf16(d0 * rstd * bf_lo(p1.x) + bf_lo(p2.x), d1 * rstd * bf_hi(p1.x) + bf_hi(p2.x)), cvt_pk_bf16(d2 * rstd * bf_lo(p1.y) + bf_lo(p2.y), d3 * rstd * bf_hi(p1.y) + bf_hi(p2.y))};
    }
}
__device__ __forceinline__ void sub_barrier(unsigned* c, unsigned target, bool arrive, int wv__) {
    __syncthreads();
    if (opaque_tid(wv__) == 0) {
        if (arrive) { __builtin_amdgcn_fence(__ATOMIC_RELEASE, "agent"); __hip_atomic_fetch_add(c, 1u, __ATOMIC_RELAXED, __HIP_MEMORY_SCOPE_AGENT); }
        while (__hip_atomic_load(c, __ATOMIC_RELAXED, __HIP_MEMORY_SCOPE_AGENT) < target) __builtin_amdgcn_s_sleep(1);
        __builtin_amdgcn_fence(__ATOMIC_ACQUIRE, "agent");
    }
    __syncthreads();
}
__device__ __forceinline__ void phase_cb_reduce(const Params& P, int wv__) {
    const int t = opaque_tid(wv__); const float* pp = (const float*)(P.ws + WS_MISC + X_CBP) + (t >> 8) * 32 * 256 + (t & 255); float sacc = 0.f;
#pragma unroll 8
    for (int c = 0; c < 32; ++c) sacc += pp[c * 256];
    ((float*)(P.ws + WS_MISC + X_CB))[t] = sacc;
}
__global__ void __launch_bounds__(512, 2) fwd_megakernel(Params P) {
    extern __shared__ __attribute__((aligned(16))) unsigned char shm_raw[];
    LAS unsigned char* shm = (LAS unsigned char*)shm_raw;
    cg::grid_group grid = cg::this_grid();
    const int bid = blockIdx.x, nb = gridDim.x, wv__ = __builtin_amdgcn_readfirstlane(threadIdx.x >> 6);
#define ws (opq_ptr(P.ws))
#define W ((bf16_t*)(ws + WS_W))
#define H ((bf16_t*)(ws + WS_H))
#define R1 ((bf16_t*)(ws + WS_R1))
#define Fb ((bf16_t*)(ws + WS_R1 + R1_F))
#define Yb ((bf16_t*)(ws + WS_Y))
#define Z3 ((bf16_t*)(ws + WS_Z3))
#define ctr ((unsigned*)(ws + WS_MISC + X_CTR))
#ifdef PROF_SEL
    if (bid == 0 && opaque_tid(wv__) == 0) { LAS long long* pa_ = (LAS long long*)(shm + 141000); pa_[0] = pa_[1] = pa_[2] = pa_[3] = pa_[4] = pa_[5] = 0; pa_[7] = wall_clock64(); }
#endif
    unsigned gk = 0;
#define GSYNC() sub_barrier(ctr + 9, (unsigned)nb * (++gk), true, wv__)
    if (nb > (1 << 24)) grid.sync();
    phase_rowpass(P.in[I_X], nullptr, nullptr, 0.f, nullptr, P.in[I_F1PRE], H, bid, nb, wv__);
    phase_convert(P, 0, shm, bid, nb, wv__);
    GSYNC(); STAMP(4);
    for (int l = 0; l < 2; ++l) {
        run_gemm(shm, H, DM, W + W_GU1, T_, 5632, DM, EpiSwiGLU{R1}, nb, bid, wv__);
        GSYNC(); STAMP(0);
        run_gemm(shm, R1, FF, W + W_D1, T_, DM, FF, EpiPlain{Fb, DM}, nb, bid, wv__);
        GSYNC(); STAMP(0);
        if (bid == nb - 1) phase_cb_reduce(P, wv__);
        phase_rowpass(l == 0 ? P.in[I_X] : P.out, Fb, P.in[I_F1POST] + (size_t)l * DM, 0.5f, P.out, P.in[I_MPRE] + (size_t)l * DM, H, bid, nb, wv__);
        GSYNC(); STAMP(4);
        run_gemm(shm, H, DM, W + W_IN, T_, LDP, DM, EpiWin{R1, (bf16_t*)(ws + WS_Z3 + M_KCIN), (bf16_t*)(ws + WS_Z3 + M_VCIN), (const f32x2*)(ws + WS_MISC + X_ROPE)}, nb, bid, wv__);
        GSYNC(); STAMP(0);
        {
            const int NR = 128, NWK = nb - NR, wb = bid - NR; unsigned* sbc = ctr + 8;
            if (bid < NR) {
                rwkv_item(P, l, bid, shm, wv__);
                STAMP(1);
                sub_barrier(sbc, (unsigned)(NWK * (3 * l + 3)), false, wv__);
            } else {
                if (wb < 8) run_gemm(shm, (const bf16_t*)(ws + WS_Z3 + M_KCIN), 1024, W + W_CK1, 2048, 256, 2048, EpiGelu{(bf16_t*)(ws + WS_Z3 + M_H1K), (const float*)(ws + WS_MISC + X_CB)}, 8, wb, wv__);
                else if (wb < 16) run_gemm(shm, (const bf16_t*)(ws + WS_Z3 + M_VCIN), 1024, W + W_CV1, 2048, 256, 2048, EpiGelu{(bf16_t*)(ws + WS_Z3 + M_H1V), (const float*)(ws + WS_MISC + X_CB) + 256}, 8, wb - 8, wv__);
                if (NWK == 128) { const int x = wb & 7, j = (wb >> 3) - 2;
                    if (j >= 0) { for (int i = j; i < 128; i += 14) ret_kv_item(P, x * 128 + i, shm, wv__);
                                  for (int i = j; i < 64; i += 14) swa_item(P, l, x * 64 + i, shm, wv__); }
                } else for (int it = wb; it < 1536; it += NWK) { if (it < 1024) ret_kv_item(P, it, shm, wv__); else swa_item(P, l, it - 1024, shm, wv__); }
                sub_barrier(sbc, (unsigned)(NWK * (3 * l + 1)), true, wv__);
                phase_cmp2(P, l, wb, NWK, wv__);
                sub_barrier(sbc, (unsigned)(NWK * (3 * l + 2)), true, wv__);
                if (NWK == 128) { const int x = wb & 7, j = wb >> 3; for (int k = 0; k < 4; ++k) nsa_cmp_item(P, x * 64 + j + 16 * k, shm, wv__); }
                else for (int it = wb; it < 512; it += NWK) nsa_cmp_item(P, it, shm, wv__);
                sub_barrier(sbc, (unsigned)(NWK * (3 * l + 3)), true, wv__);
            }
        }
        for (int sx = 0; sx < 8; ++sx) {
            const int x = (bid + sx) & 7;
            const bool t0 = opaque_tid(wv__) == 0; int nextv = 0;
            if (t0) nextv = (int)atomicAdd(ctr + 32 + l * 8 + x, 1u);
            for (;;) {
                __syncthreads();
                if (t0) *(LAS int*)(shm + L_ITEM) = nextv;
                __syncthreads();
                const int idx = *(LAS int*)(shm + L_ITEM);
                if (idx >= 192) break;
                if (t0) nextv = (int)atomicAdd(ctr + 32 + l * 8 + x, 1u);
                if (idx < 64) nsa_selwin_item(P, x + 8 * idx, shm, wv__); else ret_out_item(P, l, x * 128 + (idx - 64), shm, wv__);
            }
        }
        STAMP(2);
        GSYNC(); STAMP(3);
        phase_rwkv_ln(P, bid, nb, wv__);
        GSYNC(); STAMP(3);
        {
            const int g1 = nb / 5, g2 = g1 + 2 * (nb / 5), g3 = g2 + nb / 5;
            if (bid < g1) run_gemm(shm, Yb, 256, W + W_PNSA, T_, DM, 256, EpiPlain{R1, DM}, g1, bid, wv__);
            else if (bid < g2) run_gemm(shm, (const bf16_t*)(ws + WS_Y + Y_RET), 512, W + W_PRET, T_, DM, 512, EpiPlain{R1 + (size_t)T_ * DM, DM}, g2 - g1, bid - g1, wv__);
            else if (bid < g3) run_gemm(shm, (const bf16_t*)(ws + WS_Y + Y_RWKV), 256, W + W_PRWKV, T_, DM, 256, EpiPlain{R1 + (size_t)2 * T_ * DM, DM}, g3 - g2, bid - g2, wv__);
            else run_gemm(shm, (const bf16_t*)(ws + WS_Y + Y_SWA), 256, W + W_PSWA, T_, DM, 256, EpiPlain{Z3, DM}, nb - g3, bid - g3, wv__);
        }
        GSYNC(); STAMP(0);
        run_gemm(shm, H, DM, W + W_GATE, T_, 4096, DM, EpiMerge{{R1, R1 + (size_t)T_ * DM, R1 + (size_t)2 * T_ * DM, Z3}, Yb}, nb, bid, wv__, 1);
        GSYNC(); STAMP(0);
        run_gemm(shm, Yb, DM, W + W_OUT, T_, DM, DM, EpiPlain{Fb, DM}, nb, bid, wv__);
        GSYNC(); STAMP(0);
        phase_rowpass(P.out, Fb, P.in[I_MPOST] + (size_t)l * DM, 1.0f, P.out, P.in[I_F2PRE] + (size_t)l * DM, H, bid, nb, wv__);
        GSYNC(); STAMP(4);
        run_gemm(shm, H, DM, W + W_GU2, T_, 5632, DM, EpiSwiGLU{R1}, nb, bid, wv__);
        GSYNC(); STAMP(0);
        run_gemm(shm, R1, FF, W + W_D2, T_, DM, FF, EpiPlain{Fb, DM}, nb, bid, wv__);
        GSYNC(); STAMP(0);
        phase_rowpass(P.out, Fb, P.in[I_F2POST] + (size_t)l * DM, 0.5f, P.out, l == 0 ? P.in[I_F1PRE] + DM : nullptr, H, bid, nb, wv__);
        if (l == 0) phase_convert(P, 1, shm, bid, nb, wv__);
        GSYNC(); STAMP(4);
    }
#ifdef PROF_SEL
    if (bid == 0) { __syncthreads(); LAS long long* pa_ = (LAS long long*)(shm + 141000); const double tot = (double)(pa_[0] + pa_[1] + pa_[2] + pa_[3] + pa_[4] + pa_[5]);
        const int Kp = (PROF_SEL >= 6) ? 200000 : (int)(200000.0 * (double)pa_[PROF_SEL] / tot); for (int e = opaque_tid(wv__); e < Kp; e += 512) P.out[e] += 0.5f; }
#endif
}
#undef ws
#undef W
#undef H
#undef R1
#undef Fb
#undef Yb
#undef Z3
#undef ctr
#undef GSYNC

extern "C" void kernel_launch(void* const* d_in, const int* in_sizes, int n_in, void* d_out, int out_size, void* d_ws, size_t ws_size, hipStream_t stream) {
    static int grid_blocks = 0;
    if (grid_blocks == 0) {
        if (n_in != N_IN || out_size != T_ * DM || ws_size < WS_END) { fprintf(stderr, "kernel_launch: unexpected shapes (n_in %d out %d ws %zu)\n", n_in, out_size, ws_size); grid_blocks = -1; return; }
        int dev = 0, cus = 0, per_cu = 0;
        hipGetDevice(&dev); hipDeviceGetAttribute(&cus, hipDeviceAttributeMultiprocessorCount, dev);
        hipFuncSetAttribute((const void*)fwd_megakernel, hipFuncAttributeMaxDynamicSharedMemorySize, LDS_BYTES);
        hipOccupancyMaxActiveBlocksPerMultiprocessor(&per_cu, (const void*)fwd_megakernel, 512, LDS_BYTES);
        if (per_cu < 1) per_cu = 1;
        grid_blocks = cus * per_cu;
        if (grid_blocks < 160) { fprintf(stderr, "kernel_launch: needs >= 160 co-resident workgroups\n"); grid_blocks = -1; return; }
    }
    if (grid_blocks < 0) return;
    hipMemsetAsync((char*)d_ws + WS_MISC + X_CTR, 0, 256 + 128 * 64, stream);
#ifdef REP_IDX
    hipMemsetAsync((char*)d_ws + WS_MISC + X_CTR + 64 + REP_IDX, 1, 1, stream);
#endif
    Params p{};
    for (int i = 0; i < N_IN; ++i) p.in[i] = (const float*)d_in[i];
    p.out = (float*)d_out; p.ws = (unsigned char*)d_ws;
    void* args[] = {&p};
    hipError_t e = hipLaunchCooperativeKernel((const void*)fwd_megakernel, dim3(grid_blocks), dim3(512), args, LDS_BYTES, stream);
    if (e != hipSuccess) fprintf(stderr, "cooperative launch failed: %s (grid %d)\n", hipGetErrorString(e), grid_blocks);
}
```

```cpp
#include <hip/hip_runtime.h>
#include <hip/hip_cooperative_groups.h>
#include <cstdio>
namespace cg = cooperative_groups;

#define LAS __attribute__((address_space(3)))
typedef unsigned short bf16_t;
typedef short bf16x8 __attribute__((ext_vector_type(8)));
typedef float f32x2 __attribute__((ext_vector_type(2)));
typedef float f32x4 __attribute__((ext_vector_type(4)));
typedef float f32x16 __attribute__((ext_vector_type(16)));
typedef unsigned u32x2 __attribute__((ext_vector_type(2)));
typedef unsigned u32x4 __attribute__((ext_vector_type(4)));

constexpr int T_ = 32768, S_ = 4096, NB_ = 8, DM = 1024, FF = 2816, NCOL = 7820, LDP = 3840;
constexpr float LOG2E = 1.4426950408889634f;
constexpr int C_NSAQ = 0, C_KCMP = 256, C_VCMP = 320, C_KSLC = 384, C_VSLC = 448, C_KWIN = 512, C_VWIN = 576, C_NGATE = 640;
constexpr int C_RETQ = 704, C_RETK = 960, C_RETV = 1216, C_RETG = 1728, C_RWKV = 2240, C_SWAQ = 3264, C_SWAK = 3520, C_SWAV = 3648;

enum { I_X = 0, I_F1PRE, I_F1POST, I_F1G, I_F1U, I_F1D, I_MPRE, I_MPOST, I_WIN, I_POSK, I_POSV, I_CKW1, I_CKW2, I_CVW1, I_CVW2, I_GNG,
       I_MU, I_W0, I_W2, I_A0, I_A2, I_G2, I_KK, I_KA, I_RK, I_LNG, I_LNB, I_SINK, I_PNSA, I_PRET, I_PRWKV, I_PSWA, I_WOUT,
       I_F2PRE, I_F2POST, I_F2G, I_F2U, I_F2D, N_IN };

constexpr size_t MiB = 1048576;
constexpr size_t WS_W = 0, WS_H = 56 * MiB, WS_R1 = 120 * MiB, WS_Y = 360 * MiB, WS_Z3 = 440 * MiB, WS_MISC = 504 * MiB, WS_END = 510 * MiB;
constexpr size_t W_GU1 = 0, W_D1 = W_GU1 + (size_t)5632 * 1024, W_IN = W_D1 + (size_t)1024 * 2816, W_GATE = W_IN + (size_t)3840 * 1024,
                 W_PNSA = W_GATE + (size_t)4096 * 1024, W_PRET = W_PNSA + 262144, W_PRWKV = W_PRET + 524288, W_PSWA = W_PRWKV + 262144,
                 W_OUT = W_PSWA + 262144, W_GU2 = W_OUT + 1048576, W_D2 = W_GU2 + (size_t)5632 * 1024, W_CK1 = W_D2 + (size_t)1024 * 2816,
                 W_CV1 = W_CK1 + 524288, W_ENDE = W_CV1 + 524288;
static_assert(W_ENDE * 2 <= 56 * MiB, "weights");
constexpr size_t R1_F = (size_t)T_ * FF * 2;
constexpr size_t Y_NSA = 0, Y_RET = (size_t)T_ * 256 * 2, Y_RWKV = Y_RET + (size_t)T_ * 512 * 2, Y_SWA = Y_RWKV + (size_t)T_ * 256 * 2;
constexpr size_t M_KCIN = 0, M_VCIN = M_KCIN + ((size_t)T_ + 64) * 64 * 2, M_H1K = M_VCIN + ((size_t)T_ + 64) * 64 * 2, M_H1V = M_H1K + 2048 * 256 * 2,
                 M_KC = M_H1V + 2048 * 256 * 2, M_VC = M_KC + 2048 * 64 * 2, M_SEL = M_VC + 2048 * 64 * 2, M_KV = M_SEL + (size_t)T_ * 8,
                 M_A1 = M_KV + (size_t)1024 * 8192 * 2, M_A2 = M_A1 + (size_t)T_ * 256 * 2, M_END = M_A2 + (size_t)T_ * 256 * 2;
static_assert(M_END <= 64 * MiB, "mixer scratch");
constexpr size_t X_ROPE = 0, X_CB = X_ROPE + (size_t)S_ * 32 * 8, X_CTR = X_CB + 4096;
constexpr size_t X_FLAG = X_CTR + 256, X_XB = X_FLAG + 128 * 64, X_CBP = X_XB + 131072;

struct Params { const float* in[N_IN]; float* out; unsigned char* ws; };

typedef __bf16 bf16x2v __attribute__((ext_vector_type(2)));
__device__ __forceinline__ unsigned cvt_pk_bf16(float lo, float hi) { const f32x2 v = (f32x2){lo, hi}; const bf16x2v b = __builtin_convertvector(v, bf16x2v); return __builtin_bit_cast(unsigned, b); }
__device__ __forceinline__ float bf_lo(unsigned u) { return __uint_as_float(u << 16); }
__device__ __forceinline__ float bf_hi(unsigned u) { return __uint_as_float(u & 0xffff0000u); }
__device__ __forceinline__ float bf2f(bf16_t b) { return __uint_as_float(((unsigned)b) << 16); }
__device__ __forceinline__ float fast_exp2(float x) { return __builtin_amdgcn_exp2f(x); }
__device__ __forceinline__ float sigmoidf_(float x) { return __builtin_amdgcn_rcpf(1.0f + __builtin_amdgcn_exp2f(-1.4426950408889634f * x)); }
__device__ __forceinline__ float fast_sigmoid(float x) { return __builtin_amdgcn_rcpf(1.0f + __builtin_amdgcn_exp2f(-1.4426950408889634f * x)); }
__device__ __forceinline__ float fast_tanh(float x) { return 1.0f - 2.0f * __builtin_amdgcn_rcpf(1.0f + __builtin_amdgcn_exp2f(2.8853900817779268f * x)); }
template <int CTRL> __device__ __forceinline__ float dpp_add_(float x) { return x + __builtin_bit_cast(float, __builtin_amdgcn_update_dpp(0, __builtin_bit_cast(int, x), CTRL, 0xf, 0xf, true)); }
__device__ __forceinline__ float wave_sum(float v) {
    v = dpp_add_<0xB1>(v); v = dpp_add_<0x4E>(v); v = dpp_add_<0x141>(v); v = dpp_add_<0x140>(v);
    v += __shfl_xor(v, 16); v += __shfl_xor(v, 32);
    return v;
}
__device__ __forceinline__ int opaque_tid(int wv) { int lane_; asm volatile("v_mbcnt_lo_u32_b32 %0, -1, 0\n\tv_mbcnt_hi_u32_b32 %0, -1, %0" : "=v"(lane_)); return (wv << 6) | lane_; }
__device__ __forceinline__ unsigned char* opq_ptr(unsigned char* p) { asm volatile("" : "+s"(p)); return p; }
__device__ __forceinline__ f32x16 mfma32(bf16x8 a, bf16x8 b, f32x16 c) { return __builtin_amdgcn_mfma_f32_32x32x16_bf16(a, b, c, 0, 0, 0); }
__device__ __forceinline__ f32x16 zero16() { f32x16 z;
#pragma unroll
    for (int i = 0; i < 16; ++i) z[i] = 0.f;
    return z; }

namespace pg8 {
constexpr int BM = 256, BK = 64, HALF = 128, HTB = HALF * BK * 2, STAGE_BYTES = 8 * HTB, NXCD = 8, WGM = 8;
__device__ __forceinline__ int lds_byte(int r, int c) { const int st = (r >> 4) * 2 + (c >> 5), rr = r & 15, cc = c & 31, ob = rr * 64 + cc * 2; return st * 1024 + (ob ^ (((ob >> 9) & 1) << 5)); }
__device__ __forceinline__ void stage_rc(int b, int& R, int& C) { const int st = b / 1024, sb = b % 1024, swz = sb ^ (((sb >> 9) & 1) << 5); R = (st >> 1) * 16 + swz / 64; C = (st & 1) * 32 + (swz % 64) / 2; }
struct Unit { int pm, pn; };
struct Gemm { const bf16_t* A; const bf16_t* Bt; int M, N, K, lda; };
struct StaticOrder {
    int nM, nN, nwg, G, c, rev;
    __device__ void init(int M, int N, int G_, int c_, int rev_ = 0) { nM = M / BM; nN = N / BM; nwg = nM * nN; G = G_; c = c_; rev = rev_; }
    __device__ bool next(int i, Unit& u) const {
        const long L = (long)i * G + c; if (c < 0 || L >= nwg) return false;
        int wgid = (int)L; { const int q = nwg / NXCD, r = nwg % NXCD, xcd = wgid % NXCD, off = wgid / NXCD; wgid = (xcd < r ? xcd * (q + 1) : r * (q + 1) + (xcd - r) * q) + off; }
        const int nig = WGM * nN, gid = wgid / nig, fm = gid * WGM, gsz = (nM - fm) < WGM ? (nM - fm) : WGM;
        u.pm = fm + ((wgid % nig) % gsz); u.pn = (wgid % nig) / gsz; if (rev) u.pm = nM - 1 - u.pm;
        return true;
    }
};
template <class Epi, class Sched>
__device__ __forceinline__ void gemm_phase(LAS unsigned char* lds, const Gemm g, const Sched& S, const Epi& E, int wv__) {
    const int tid = opaque_tid(wv__), wid = __builtin_amdgcn_readfirstlane(tid >> 6), lane = tid & 63, wr = wid >> 2, wc = wid & 3, fr = lane & 15, fq = lane >> 4;
    const int K = g.K, nt = K / BK, lda = g.lda;
    unsigned voffA[2], voffB[2];
#pragma unroll
    for (int i = 0; i < 2; ++i) { int R, C; stage_rc(tid * 16 + i * 8192, R, C); voffA[i] = (unsigned)(R * lda + C) * 2u; voffB[i] = (unsigned)(R * K + C) * 2u; }
    const size_t kstep = (size_t)(BK * 2);
    const size_t hstepA = (size_t)HALF * lda * 2, hstepB = (size_t)HALF * K * 2;
    const size_t tstepA = 2 * hstepA, tstepB = 2 * hstepB;
    const unsigned ldsw = (unsigned)wid * 1024u;
    const int aoff = lds_byte(wr * 64 + fr, fq * 8), boff = lds_byte(wc * 32 + fr, fq * 8);
#define PG8_SA(b, h) (((b) * 2 + (h)) * HTB)
#define PG8_SB(b, h) ((4 + (b) * 2 + (h)) * HTB)
#define PG8_STAGE(bufoff, gbase, voff) do { _Pragma("unroll") for (int _i = 0; _i < 2; ++_i) \
        __builtin_amdgcn_global_load_lds((const unsigned*)((const char*)(gbase) + (voff)[_i]), (LAS unsigned*)(lds + (bufoff) + ldsw + _i * 8192), 16, 0, 0); } while (0)
#define PG8_LDA(dst, b, h) do { _Pragma("unroll") for (int m = 0; m < 4; ++m) _Pragma("unroll") for (int k = 0; k < 2; ++k) dst[m][k] = *(const LAS bf16x8*)(lds + PG8_SA(b, h) + aoff + m * 2048 + k * 1024); } while (0)
#define PG8_LDB(dst, b, h) do { _Pragma("unroll") for (int n = 0; n < 2; ++n) _Pragma("unroll") for (int k = 0; k < 2; ++k) dst[n][k] = *(const LAS bf16x8*)(lds + PG8_SB(b, h) + boff + n * 2048 + k * 1024); } while (0)
#define PG8_MMA(ai, bj, At, Bt) do { __builtin_amdgcn_s_setprio(1); _Pragma("unroll") for (int m = 0; m < 4; ++m) _Pragma("unroll") for (int n = 0; n < 2; ++n) _Pragma("unroll") for (int k = 0; k < 2; ++k) \
        acc[ai][bj][m][n] = __builtin_amdgcn_mfma_f32_16x16x32_bf16(Bt[n][k], At[m][k], acc[ai][bj][m][n], 0, 0, 0); __builtin_amdgcn_s_setprio(0); } while (0)
#define PG8_WAIT_V(n) asm volatile("s_waitcnt vmcnt(" #n ")" ::: "memory")
#define PG8_WAIT_L(n) asm volatile("s_waitcnt lgkmcnt(" #n ")" ::: "memory")
#define PG8_BAR __builtin_amdgcn_s_barrier()
#define PG8_SCHED __builtin_amdgcn_sched_barrier(0)
    Unit cur, nxt; int ui = 0;
    (void)S.next(0, cur);
    f32x4 acc[2][2][4][2];
#pragma unroll
    for (int a = 0; a < 2; ++a)
#pragma unroll
        for (int b = 0; b < 2; ++b)
#pragma unroll
            for (int m = 0; m < 4; ++m)
#pragma unroll
                for (int n = 0; n < 2; ++n) acc[a][b][m][n] = (f32x4){0.f, 0.f, 0.f, 0.f};
    bf16x8 At[4][2], B0[2][2], B1[2][2];
    const char* cA = (const char*)g.A + (size_t)cur.pm * tstepA; const char* cB = (const char*)g.Bt + (size_t)cur.pn * tstepB;
    PG8_STAGE(PG8_SB(0, 0), cB, voffB); PG8_STAGE(PG8_SA(0, 0), cA, voffA); PG8_STAGE(PG8_SB(0, 1), cB + hstepB, voffB); PG8_STAGE(PG8_SA(0, 1), cA + hstepA, voffA);
    if (wr == 1) PG8_BAR;
    PG8_WAIT_V(4); PG8_BAR;
    PG8_STAGE(PG8_SB(1, 0), cB + kstep, voffB); PG8_STAGE(PG8_SA(1, 0), cA + kstep, voffA); PG8_STAGE(PG8_SB(1, 1), cB + hstepB + kstep, voffB);
    PG8_WAIT_V(6); PG8_BAR;
    for (;;) {
        const bool has_next = S.next(ui + 1, nxt);
        const char* nA = has_next ? (const char*)g.A + (size_t)nxt.pm * tstepA : cA; const char* nB = has_next ? (const char*)g.Bt + (size_t)nxt.pn * tstepB : cB;
        for (int t = 0; t < nt; t += 2) {
            const bool last = (t == nt - 2);
            const char* a1 = cA + (size_t)(t + 1) * kstep;
            const char* a2 = last ? nA : cA + (size_t)(t + 2) * kstep; const char* b2 = last ? nB : cB + (size_t)(t + 2) * kstep;
            const char* a3 = a2 + kstep; const char* b3 = b2 + kstep;
            PG8_LDB(B0, 0, 0); PG8_SCHED; PG8_LDA(At, 0, 0); PG8_STAGE(PG8_SA(1, 1), a1 + hstepA, voffA);
            PG8_WAIT_L(8); PG8_BAR; PG8_WAIT_L(0); PG8_MMA(0, 0, At, B0); PG8_BAR; PG8_SCHED;
            PG8_LDB(B1, 0, 1); PG8_STAGE(PG8_SB(0, 0), b2, voffB);
            PG8_BAR; PG8_WAIT_L(0); PG8_MMA(0, 1, At, B1); PG8_BAR;
            PG8_LDA(At, 0, 1); PG8_STAGE(PG8_SA(0, 0), a2, voffA);
            PG8_BAR; PG8_WAIT_L(0); PG8_MMA(1, 0, At, B0); PG8_BAR; PG8_SCHED;
            PG8_STAGE(PG8_SB(0, 1), b2 + hstepB, voffB);
            PG8_WAIT_V(6); PG8_BAR; PG8_MMA(1, 1, At, B1); PG8_BAR;
            PG8_LDB(B0, 1, 0); PG8_SCHED; PG8_LDA(At, 1, 0); PG8_STAGE(PG8_SA(0, 1), a2 + hstepA, voffA);
            PG8_WAIT_L(8); PG8_BAR; PG8_WAIT_L(0); PG8_MMA(0, 0, At, B0); PG8_BAR; PG8_SCHED;
            PG8_LDB(B1, 1, 1); PG8_STAGE(PG8_SB(1, 0), b3, voffB);
            PG8_BAR; PG8_WAIT_L(0); PG8_MMA(0, 1, At, B1); PG8_BAR;
            PG8_LDA(At, 1, 1); PG8_STAGE(PG8_SA(1, 0), a3, voffA);
            PG8_BAR; PG8_WAIT_L(0); PG8_MMA(1, 0, At, B0); PG8_BAR; PG8_SCHED;
            PG8_STAGE(PG8_SB(1, 1), b3 + hstepB, voffB);
            PG8_WAIT_V(6); PG8_BAR; PG8_MMA(1, 1, At, B1); PG8_BAR;
        }
        E(acc, cur, wr, wc, fr, fq);
        if (!has_next) break;
#pragma unroll
        for (int a = 0; a < 2; ++a)
#pragma unroll
            for (int b = 0; b < 2; ++b)
#pragma unroll
                for (int m = 0; m < 4; ++m)
#pragma unroll
                    for (int n = 0; n < 2; ++n) acc[a][b][m][n] = (f32x4){0.f, 0.f, 0.f, 0.f};
        cur = nxt; cA = nA; cB = nB; ++ui;
    }
    PG8_WAIT_V(0);
    if (wr == 0) PG8_BAR;
    PG8_BAR;
#undef PG8_SA
#undef PG8_SB
#undef PG8_STAGE
#undef PG8_LDA
#undef PG8_LDB
#undef PG8_MMA
#undef PG8_WAIT_V
#undef PG8_WAIT_L
#undef PG8_BAR
#undef PG8_SCHED
}
}
using pg8::Unit;
typedef f32x4 AccT[2][2][4][2];

struct EpiPlain {
    bf16_t* O; int ldc;
    __device__ __forceinline__ void operator()(const AccT& acc, const Unit& u, int wr, int wc, int fr, int fq) const {
        const int row0 = u.pm * 256 + wr * 64 + fr, col0 = u.pn * 256 + wc * 32 + 4 * fq;
#pragma unroll
        for (int ai = 0; ai < 2; ++ai)
#pragma unroll
            for (int m = 0; m < 4; ++m) { bf16_t* rowp = O + (size_t)(row0 + ai * 128 + m * 16) * ldc + col0;
#pragma unroll
                for (int bj = 0; bj < 2; ++bj)
#pragma unroll
                    for (int n = 0; n < 2; ++n) { const f32x4 v = acc[ai][bj][m][n]; *(u32x2*)(rowp + bj * 128 + n * 16) = (u32x2){cvt_pk_bf16(v[0], v[1]), cvt_pk_bf16(v[2], v[3])}; } }
    }
};
struct EpiSwiGLU {
    bf16_t* O;
    __device__ __forceinline__ void operator()(const AccT& acc, const Unit& u, int wr, int wc, int fr, int fq) const {
        const int row0 = u.pm * 256 + wr * 64 + fr, col0 = u.pn * 128 + wc * 32 + 4 * fq;
#pragma unroll
        for (int ai = 0; ai < 2; ++ai)
#pragma unroll
            for (int m = 0; m < 4; ++m) { bf16_t* rowp = O + (size_t)(row0 + ai * 128 + m * 16) * FF + col0;
#pragma unroll
                for (int n = 0; n < 2; ++n) { const f32x4 g = acc[ai][0][m][n], up = acc[ai][1][m][n]; float r[4];
#pragma unroll
                    for (int i = 0; i < 4; ++i) r[i] = g[i] * up[i] * fast_sigmoid(g[i]);
                    *(u32x2*)(rowp + n * 16) = (u32x2){cvt_pk_bf16(r[0], r[1]), cvt_pk_bf16(r[2], r[3])}; } }
    }
};
struct EpiGelu {
    bf16_t* O; const float* bias;
    __device__ __forceinline__ void operator()(const AccT& acc, const Unit& u, int wr, int wc, int fr, int fq) const {
        const int row0 = u.pm * 256 + wr * 64 + fr, col0 = u.pn * 256 + wc * 32 + 4 * fq;
#pragma unroll
        for (int ai = 0; ai < 2; ++ai)
#pragma unroll
            for (int m = 0; m < 4; ++m) { bf16_t* rowp = O + (size_t)(row0 + ai * 128 + m * 16) * 256 + col0;
#pragma unroll
                for (int bj = 0; bj < 2; ++bj)
#pragma unroll
                    for (int n = 0; n < 2; ++n) { const f32x4 v = acc[ai][bj][m][n]; const f32x4 b = *(const f32x4*)(bias + col0 + bj * 128 + n * 16); float r[4];
#pragma unroll
                        for (int i = 0; i < 4; ++i) { const float x = v[i] + b[i]; const float u2 = 1.5957691216057308f * (x + 0.044715f * x * x * x); r[i] = x * sigmoidf_(u2); }
                        *(u32x2*)(rowp + bj * 128 + n * 16) = (u32x2){cvt_pk_bf16(r[0], r[1]), cvt_pk_bf16(r[2], r[3])}; } }
    }
};
struct EpiWin {
    bf16_t* P; bf16_t* kcin; bf16_t* vcin; const f32x2* rope;
    __device__ __forceinline__ static bool roped(int hb) { return hb == C_KSLC || hb == C_KWIN || (hb >= C_RETK && hb < C_RETV) || (hb >= C_SWAK && hb < C_SWAV); }
    __device__ __forceinline__ void operator()(const AccT& acc, const Unit& u, int wr, int wc, int fr, int fq) const {
        const int row0 = u.pm * 256 + wr * 64 + fr;
#pragma unroll
        for (int bj = 0; bj < 2; ++bj) {
            const int base = u.pn * 256 + bj * 128 + wc * 32;
            const int hb = base & ~63;
            if (roped(hb)) {
                const int d1 = 16 * (wc & 1) + 4 * fq;
#pragma unroll
                for (int ai = 0; ai < 2; ++ai)
#pragma unroll
                    for (int m = 0; m < 4; ++m) { const int row = row0 + ai * 128 + m * 16; const f32x2* cs = rope + (size_t)(row & (S_ - 1)) * 32 + d1;
                        const f32x4 c01 = *(const f32x4*)cs, c23 = *(const f32x4*)(cs + 2);
                        const f32x4 a = acc[ai][bj][m][0], b = acc[ai][bj][m][1];
                        const float co[4] = {c01[0], c01[2], c23[0], c23[2]}, si[4] = {c01[1], c01[3], c23[1], c23[3]}; float o1[4], o2[4];
#pragma unroll
                        for (int i = 0; i < 4; ++i) { o1[i] = a[i] * co[i] - b[i] * si[i]; o2[i] = b[i] * co[i] + a[i] * si[i]; }
                        bf16_t* rp = P + (size_t)row * LDP + hb + d1;
                        *(u32x2*)rp = (u32x2){cvt_pk_bf16(o1[0], o1[1]), cvt_pk_bf16(o1[2], o1[3])};
                        *(u32x2*)(rp + 32) = (u32x2){cvt_pk_bf16(o2[0], o2[1]), cvt_pk_bf16(o2[2], o2[3])}; }
            } else {
#pragma unroll
                for (int ai = 0; ai < 2; ++ai)
#pragma unroll
                    for (int m = 0; m < 4; ++m) { const int row = row0 + ai * 128 + m * 16;
#pragma unroll
                        for (int n = 0; n < 2; ++n) { const int col = base + n * 16 + 4 * fq; const f32x4 v = acc[ai][bj][m][n];
                            const u32x2 w = (u32x2){cvt_pk_bf16(v[0], v[1]), cvt_pk_bf16(v[2], v[3])};
                            *(u32x2*)(P + (size_t)row * LDP + col) = w;
                            if (hb == C_KCMP) *(u32x2*)(kcin + (size_t)row * 64 + (col - C_KCMP)) = w;
                            if (hb == C_VCMP) *(u32x2*)(vcin + (size_t)row * 64 + (col - C_VCMP)) = w; } }
            }
        }
    }
};
struct EpiMerge {
    const bf16_t* Z[4]; bf16_t* O;
    __device__ __forceinline__ void operator()(const AccT& acc, const Unit& u, int wr, int wc, int fr, int fq) const {
        const int row0 = u.pm * 256 + wr * 64 + fr, col = u.pn * 64 + wc * 16 + 4 * fq;
#pragma unroll
        for (int ai = 0; ai < 2; ++ai) {
            u32x2 zz[4][4];
#pragma unroll
            for (int m = 0; m < 4; ++m) { const size_t off = (size_t)(row0 + ai * 128 + m * 16) * DM + col;
#pragma unroll
                for (int br = 0; br < 4; ++br) zz[m][br] = *(const u32x2*)(Z[br] + off); }
#pragma unroll
            for (int m = 0; m < 4; ++m) { const size_t off = (size_t)(row0 + ai * 128 + m * 16) * DM + col; float r[4] = {0.f, 0.f, 0.f, 0.f};
#pragma unroll
                for (int br = 0; br < 4; ++br) { const f32x4 g = acc[ai][br >> 1][m][br & 1]; const u32x2 z = zz[m][br];
                    r[0] += fast_sigmoid(g[0]) * bf_lo(z[0]); r[1] += fast_sigmoid(g[1]) * bf_hi(z[0]); r[2] += fast_sigmoid(g[2]) * bf_lo(z[1]); r[3] += fast_sigmoid(g[3]) * bf_hi(z[1]); }
                *(u32x2*)(O + off) = (u32x2){cvt_pk_bf16(r[0], r[1]), cvt_pk_bf16(r[2], r[3])}; }
        }
    }
};

template <class Epi>
__device__ __forceinline__ void run_gemm(LAS unsigned char* lds, const bf16_t* A, int lda, const bf16_t* Bt, int M, int N, int K, const Epi& E, int G, int c, int wv__, int rev = 0) {
    pg8::Gemm g; g.A = A; g.Bt = Bt; g.M = M; g.N = N; g.K = K; g.lda = lda;
    pg8::StaticOrder S; S.init(M, N, G, c, rev);
    pg8::gemm_phase<Epi, pg8::StaticOrder>(lds, g, S, E, wv__);
}

struct MapId { const float* src; int ld; __device__ const float* ptr(int n) const { return src + n; } };
struct MapGU { const float* g; const float* u; int ld; __device__ const float* ptr(int n) const { const int j = n >> 8, w = n & 255; return (w < 128) ? g + 128 * j + w : u + 128 * j + (w - 128); } };
__device__ __forceinline__ int swap45(int x) { return (x & ~48) | ((x & 16) << 1) | ((x & 32) >> 1); }
struct MapWin { const float* src; int ld;
    __device__ const float* ptr(int n) const {
        if (n >= 3776 || (n >= 652 && n < 704)) return nullptr;
        const int hb = n & ~63; int c = n;
        if (EpiWin::roped(hb)) c = hb + swap45(n - hb);
        return src + (c < 652 ? c : c - 52); } };
struct MapGate { const float* src; int ld;
    __device__ const float* ptr(int n) const { const int pn = n >> 8, rho = n & 255, bj = rho >> 7, wc = (rho >> 5) & 3, nn = (rho >> 4) & 1, q = rho & 15;
        return src + 3724 + (2 * bj + nn) * 1024 + 64 * pn + 16 * wc + q; } };

template <class Map>
__device__ __forceinline__ void conv_tiles(const Map mp, int K, int N, bf16_t* dst, LAS float* tile, int& item_base, int bid, int nb, int wv__) {
    const int nn = N / 64, total = (K / 64) * nn, tid = opaque_tid(wv__);
    const int first = (bid - (item_base % nb) + nb) % nb;
    const int ty = tid >> 6, tx = tid & 63, wn = tid >> 3, kc = tid & 7;
    for (int it0 = first; it0 < total; it0 += 4 * nb) {
#pragma unroll
        for (int u = 0; u < 4; ++u) { const int it = it0 + u * nb; if (it < total) { const int k0 = (it / nn) * 64, n0 = (it % nn) * 64; const float* sp = mp.ptr(n0 + tx); LAS float* tl = tile + u * 4160;
#pragma unroll
            for (int kk = ty; kk < 64; kk += 8) tl[kk * 65 + tx] = sp ? sp[(size_t)(k0 + kk) * mp.ld] : 0.f; } }
        __syncthreads();
#pragma unroll
        for (int u = 0; u < 4; ++u) { const int it = it0 + u * nb; if (it < total) { const int k0 = (it / nn) * 64, n0 = (it % nn) * 64; const LAS float* sl = tile + u * 4160 + (8 * kc) * 65 + wn;
            u32x4 o; o.x = cvt_pk_bf16(sl[0], sl[65]); o.y = cvt_pk_bf16(sl[2 * 65], sl[3 * 65]); o.z = cvt_pk_bf16(sl[4 * 65], sl[5 * 65]); o.w = cvt_pk_bf16(sl[6 * 65], sl[7 * 65]);
            *(u32x4*)(dst + (size_t)(n0 + wn) * K + k0 + 8 * kc) = o; } }
        __syncthreads();
    }
    item_base += total;
}

__device__ __forceinline__ void phase_convert(const Params& P, int l, LAS unsigned char* lds, int bid, int nb, int wv__) {
    const int ctid = opaque_tid(wv__); bf16_t* W = (bf16_t*)(P.ws + WS_W); LAS float* tile = (LAS float*)lds;
    {
        constexpr int NM = 13;
        const int mK[NM] = {DM, FF, DM, DM, 256, 512, 256, 256, DM, DM, FF, 2048, 2048};
        const int mN[NM] = {5632, DM, LDP, 4096, DM, DM, DM, DM, DM, 5632, DM, 256, 256};
        const size_t mD[NM] = {W_GU1, W_D1, W_IN, W_GATE, W_PNSA, W_PRET, W_PRWKV, W_PSWA, W_OUT, W_GU2, W_D2, W_CK1, W_CV1};
        int total = 0;
#pragma unroll
        for (int m = 0; m < NM; ++m) total += (mK[m] / 64) * (mN[m] / 64);
        const int ty = ctid >> 6, tx = ctid & 63, wn = ctid >> 3, kc = ctid & 7;
        const float* win = P.in[I_WIN] + (size_t)l * DM * NCOL;
        int tk0[4], tn0[4], tm[4]; float vals[4][8];
        auto decode_load = [&](int g0) {
#pragma unroll
            for (int u = 0; u < 4; ++u) { int g = g0 + u * nb; tm[u] = -1; tk0[u] = 0; tn0[u] = 0;
                if (g < total) {
#pragma unroll
                    for (int m = 0; m < NM; ++m) { const int nn = mN[m] / 64, cnt = (mK[m] / 64) * nn; if (tm[u] < 0) { if (g < cnt) { tm[u] = m; tk0[u] = (g / nn) * 64; tn0[u] = (g % nn) * 64; } else g -= cnt; } } } }
#pragma unroll
            for (int u = 0; u < 4; ++u) {
#pragma unroll
                for (int e = 0; e < 8; ++e) vals[u][e] = 0.f;
                if (tm[u] >= 0) { const int m = tm[u], n = tn0[u] + tx; const float* sp; int ld;
                    switch (m) {
                        case 0: sp = MapGU{P.in[I_F1G] + (size_t)l * DM * FF, P.in[I_F1U] + (size_t)l * DM * FF, FF}.ptr(n); ld = FF; break;
                        case 1: sp = P.in[I_F1D] + (size_t)l * FF * DM + n; ld = DM; break;
                        case 2: sp = MapWin{win, NCOL}.ptr(n); ld = NCOL; break;
                        case 3: sp = MapGate{win, NCOL}.ptr(n); ld = NCOL; break;
                        case 4: sp = P.in[I_PNSA] + (size_t)l * 256 * DM + n; ld = DM; break;
                        case 5: sp = P.in[I_PRET] + (size_t)l * 512 * DM + n; ld = DM; break;
                        case 6: sp = P.in[I_PRWKV] + (size_t)l * 256 * DM + n; ld = DM; break;
                        case 7: sp = P.in[I_PSWA] + (size_t)l * 256 * DM + n; ld = DM; break;
                        case 8: sp = P.in[I_WOUT] + (size_t)l * DM * DM + n; ld = DM; break;
                        case 9: sp = MapGU{P.in[I_F2G] + (size_t)l * DM * FF, P.in[I_F2U] + (size_t)l * DM * FF, FF}.ptr(n); ld = FF; break;
                        case 10: sp = P.in[I_F2D] + (size_t)l * FF * DM + n; ld = DM; break;
                        case 11: sp = P.in[I_CKW1] + (size_t)l * 2048 * 256 + n; ld = 256; break;
                        default: sp = P.in[I_CVW1] + (size_t)l * 2048 * 256 + n; ld = 256; break;
                    }
                    if (sp) {
#pragma unroll
                        for (int e = 0; e < 8; ++e) vals[u][e] = sp[(size_t)(tk0[u] + ty + 8 * e) * ld]; } } } };
        decode_load(bid);
        for (int g0 = bid; g0 < total; g0 += 4 * nb) {
            int ck0[4], cn0[4], cm[4];
#pragma unroll
            for (int u = 0; u < 4; ++u) { ck0[u] = tk0[u]; cn0[u] = tn0[u]; cm[u] = tm[u];
                if (tm[u] >= 0) { LAS float* tl = tile + u * 4160;
#pragma unroll
                    for (int e = 0; e < 8; ++e) tl[(ty + 8 * e) * 65 + tx] = vals[u][e]; } }
            __syncthreads();
            if (g0 + 4 * nb < total) decode_load(g0 + 4 * nb);
#pragma unroll
            for (int u = 0; u < 4; ++u) if (cm[u] >= 0) { const LAS float* sl = tile + u * 4160 + (8 * kc) * 65 + wn;
                u32x4 o; o.x = cvt_pk_bf16(sl[0], sl[65]); o.y = cvt_pk_bf16(sl[2 * 65], sl[3 * 65]); o.z = cvt_pk_bf16(sl[4 * 65], sl[5 * 65]); o.w = cvt_pk_bf16(sl[6 * 65], sl[7 * 65]);
                *(u32x4*)(W + mD[cm[u]] + (size_t)(cn0[u] + wn) * mK[cm[u]] + ck0[u] + 8 * kc) = o; }
            __syncthreads();
        }
    }
    if (bid < 64) {
        const int kv = bid >> 5, cidx = bid & 31, j = ctid & 255, half = ctid >> 8;
        const float* pos = P.in[kv ? I_POSV : I_POSK] + (size_t)l * 2048 + 64 * cidx + 32 * half; const float* w1 = P.in[kv ? I_CVW1 : I_CKW1] + (size_t)l * 2048 * 256 + (size_t)(64 * cidx + 32 * half) * 256 + j;
        float sacc = 0.f;
#pragma unroll 8
        for (int i = 0; i < 32; ++i) sacc += pos[i] * w1[(size_t)i * 256];
        __syncthreads();
        if (half) tile[j] = sacc;
        __syncthreads();
        if (!half) ((float*)(P.ws + WS_MISC + X_CBP))[(kv * 32 + cidx) * 256 + j] = sacc + tile[j];
        __syncthreads();
    }
    if (l == 0) {
        f32x2* rope = (f32x2*)(P.ws + WS_MISC + X_ROPE);
        for (int e = bid * 512 + ctid; e < S_ * 32; e += nb * 512) {
            const int pos = e >> 5, i = e & 31; const float invf = powf(10000.0f, -(float)i * 2.0f / 64.0f); const float ang = (float)pos * invf;
            double a = (double)ang; const double k = rint(a * 0.15915494309189535); a -= k * 6.283185307179586;
            const float af = (float)a; rope[e] = (f32x2){cosf(af), sinf(af)}; }
        bf16_t* kc = (bf16_t*)(P.ws + WS_Z3 + M_KCIN); bf16_t* vc = (bf16_t*)(P.ws + WS_Z3 + M_VCIN);
        for (int e = bid * 512 + ctid; e < 64 * 64; e += nb * 512) { kc[(size_t)T_ * 64 + e] = 0; vc[(size_t)T_ * 64 + e] = 0; }
    }
}

__device__ __forceinline__ void phase_rowpass(const float* xin, const bf16_t* F, const float* gpost, float coef, float* xout, const float* gpre, bf16_t* h, int bid, int nb, int wv__) {
    const int tid_ = opaque_tid(wv__), lane = tid_ & 63, gw = bid * 8 + (tid_ >> 6), NGW = nb * 8;
    f32x4 gpo[4], gpr[4];
#pragma unroll
    for (int j = 0; j < 4; ++j) { gpo[j] = F ? ((const f32x4*)gpost)[64 * j + lane] : (f32x4){0.f, 0.f, 0.f, 0.f}; gpr[j] = gpre ? ((const f32x4*)gpre)[64 * j + lane] : (f32x4){0.f, 0.f, 0.f, 0.f}; }
    f32x4 xn[4]; u32x2 fn[4];
    if (gw < T_) {
#pragma unroll
        for (int j = 0; j < 4; ++j) { xn[j] = ((const f32x4*)(xin + (size_t)gw * DM) + lane)[64 * j]; fn[j] = F ? ((const u32x2*)(F + (size_t)gw * DM) + lane)[64 * j] : (u32x2){0u, 0u}; } }
    for (int row = gw; row < T_; row += NGW) {
        f32x4 x[4]; u32x2 fw[4];
#pragma unroll
        for (int j = 0; j < 4; ++j) { x[j] = xn[j]; fw[j] = fn[j]; }
        const int nrow = row + NGW;
        if (nrow < T_) {
#pragma unroll
            for (int j = 0; j < 4; ++j) { xn[j] = ((const f32x4*)(xin + (size_t)nrow * DM) + lane)[64 * j]; fn[j] = F ? ((const u32x2*)(F + (size_t)nrow * DM) + lane)[64 * j] : (u32x2){0u, 0u}; } }
        if (F) {
            f32x4 f[4]; float s = 0.f;
#pragma unroll
            for (int j = 0; j < 4; ++j) { const u32x2 w = fw[j]; f[j] = (f32x4){bf_lo(w[0]), bf_hi(w[0]), bf_lo(w[1]), bf_hi(w[1])}; s += (f[j][0] * f[j][0] + f[j][1] * f[j][1]) + (f[j][2] * f[j][2] + f[j][3] * f[j][3]); }
            const float rs = coef * rsqrtf(wave_sum(s) * (1.0f / DM) + 1e-6f);
#pragma unroll
            for (int j = 0; j < 4; ++j) x[j] = x[j] + f[j] * gpo[j] * rs;
        }
        f32x4* xo = (f32x4*)(xout + (size_t)row * DM) + lane;
#pragma unroll
        for (int j = 0; j < 4; ++j) if (xout) xo[64 * j] = x[j];
        if (gpre) {
            float s = 0.f;
#pragma unroll
            for (int j = 0; j < 4; ++j) s += (x[j][0] * x[j][0] + x[j][1] * x[j][1]) + (x[j][2] * x[j][2] + x[j][3] * x[j][3]);
            const float rs = rsqrtf(wave_sum(s) * (1.0f / DM) + 1e-6f);
            u32x2* ho = (u32x2*)(h + (size_t)row * DM) + lane;
#pragma unroll
            for (int j = 0; j < 4; ++j) { const f32x4 v = x[j] * gpr[j] * rs; ho[64 * j] = (u32x2){cvt_pk_bf16(v[0], v[1]), cvt_pk_bf16(v[2], v[3])}; }
        }
    }
}

constexpr int A_KS = 0, A_VTS = 9216, A_MISC = 32768, A_BUF1 = 57344;
struct QF { bf16x8 f[4]; };
__device__ __forceinline__ bf16x8 pack8(const float* v) { u32x4 w = (u32x4){cvt_pk_bf16(v[0], v[1]), cvt_pk_bf16(v[2], v[3]), cvt_pk_bf16(v[4], v[5]), cvt_pk_bf16(v[6], v[7])}; return __builtin_bit_cast(bf16x8, w); }
__device__ __forceinline__ void load_q(QF& q, const bf16_t* qrow, int h, const f32x2* ropeRow, float scale) {
    float v[4][8];
#pragma unroll
    for (int ks = 0; ks < 4; ++ks) { const u32x4 w = *(const u32x4*)(qrow + 16 * ks + 8 * h);
        v[ks][0] = bf_lo(w.x); v[ks][1] = bf_hi(w.x); v[ks][2] = bf_lo(w.y); v[ks][3] = bf_hi(w.y); v[ks][4] = bf_lo(w.z); v[ks][5] = bf_hi(w.z); v[ks][6] = bf_lo(w.w); v[ks][7] = bf_hi(w.w); }
    if (ropeRow) {
#pragma unroll
        for (int ks = 0; ks < 2; ++ks)
#pragma unroll
            for (int j = 0; j < 8; ++j) { const f32x2 cs = ropeRow[16 * ks + 8 * h + j]; const float a = v[ks][j], b = v[ks + 2][j]; v[ks][j] = a * cs.x - b * cs.y; v[ks + 2][j] = b * cs.x + a * cs.y; }
    }
#pragma unroll
    for (int ks = 0; ks < 4; ++ks) {
#pragma unroll
        for (int j = 0; j < 8; ++j) v[ks][j] *= scale;
        q.f[ks] = pack8(v[ks]); }
}
__device__ __forceinline__ void qk_tile(const LAS unsigned char* Ks, const QF& q, int r, int h, f32x16 (&s)[2]) {
#pragma unroll
    for (int kt = 0; kt < 2; ++kt) { s[kt] = zero16();
#pragma unroll
        for (int ks = 0; ks < 4; ++ks) { const bf16x8 a = *(const LAS bf16x8*)(Ks + ((32 * kt + r) * 72 + 16 * ks + 8 * h) * 2); s[kt] = mfma32(a, q.f[ks], s[kt]); } }
}
__device__ __forceinline__ void pv_tile(const LAS unsigned char* Vts, int vrow0, const f32x16 (&p)[2], int r, int h, f32x16 (&o)[2]) {
#pragma unroll
    for (int kt = 0; kt < 2; ++kt)
#pragma unroll
        for (int s2 = 0; s2 < 2; ++s2) { float t[8];
#pragma unroll
            for (int j = 0; j < 8; ++j) t[j] = p[kt][8 * s2 + j];
            const bf16x8 pf = pack8(t);
#pragma unroll
            for (int dt = 0; dt < 2; ++dt) { const LAS unsigned char* ap = Vts + ((vrow0 + 32 * dt + r) * 68 + 32 * kt + 16 * s2 + 4 * h) * 2;
                const u32x2 lo = *(const LAS u32x2*)ap, hi = *(const LAS u32x2*)(ap + 16);
                const bf16x8 a = __builtin_bit_cast(bf16x8, (u32x4){lo.x, lo.y, hi.x, hi.y}); o[dt] = mfma32(a, pf, o[dt]); } }
}
template <bool FULL>
__device__ __forceinline__ void softmax_update(f32x16 (&s)[2], int lo, int hi, int h, float& m, float& l, f32x16 (&o)[2]) {
    float mx = m;
#pragma unroll
    for (int kt = 0; kt < 2; ++kt)
#pragma unroll
        for (int reg = 0; reg < 16; ++reg) {
            if (!FULL) { const int kl = 32 * kt + (reg & 3) + 8 * (reg >> 2) + 4 * h; const bool v = (kl >= lo) && (kl <= hi); s[kt][reg] = v ? s[kt][reg] : -INFINITY; }
            mx = fmaxf(mx, s[kt][reg]); }
    mx = fmaxf(mx, __shfl_xor(mx, 32));
    if (__any(mx > m)) {
        const float alpha = fast_exp2(m - mx); m = mx; l *= alpha;
#pragma unroll
        for (int dt = 0; dt < 2; ++dt) o[dt] = o[dt] * alpha;
    }
    float ls = 0.f;
#pragma unroll
    for (int kt = 0; kt < 2; ++kt)
#pragma unroll
        for (int reg = 0; reg < 16; ++reg) { const float p = fast_exp2(s[kt][reg] - mx); s[kt][reg] = p; ls += p; }
    l += ls;
}
__device__ __forceinline__ void store_kv_tile(LAS unsigned char* shm, u32x4 kreg, u32x4 vreg, int key, int c) {
    *(LAS u32x4*)(shm + A_KS + key * 144 + c * 16) = kreg;
    LAS bf16_t* vt = (LAS bf16_t*)(shm + A_VTS) + (8 * c) * 68 + key;
    vt[0] = (bf16_t)(vreg.x & 0xffff); vt[68] = (bf16_t)(vreg.x >> 16); vt[136] = (bf16_t)(vreg.y & 0xffff); vt[204] = (bf16_t)(vreg.y >> 16);
    vt[272] = (bf16_t)(vreg.z & 0xffff); vt[340] = (bf16_t)(vreg.z >> 16); vt[408] = (bf16_t)(vreg.w & 0xffff); vt[476] = (bf16_t)(vreg.w >> 16);
}
template <int MODE, class TR, class MK>
__device__ __forceinline__ void flash_loop(int ntiles, TR tileRow, MK maskAt, const bf16_t* Kg, const bf16_t* Vg, int ld, const QF& q, float& m, float& l, f32x16 (&o)[2],
                                           LAS unsigned char* shm, int tid, int lane, float inv = 0.f, LAS float* imp = nullptr, int qloc = 0) {
    if (ntiles <= 0) return;
    const int key = tid >> 3, c = tid & 7, r = lane & 31, h = lane >> 5;
    u32x4 kreg0, vreg0, kreg1 = (u32x4){0u, 0u, 0u, 0u}, vreg1 = (u32x4){0u, 0u, 0u, 0u};
    { const size_t off = (size_t)(tileRow(0) + key) * ld + 8 * c; kreg0 = *(const u32x4*)(Kg + off); vreg0 = *(const u32x4*)(Vg + off); }
    if (ntiles > 1) { const size_t off = (size_t)(tileRow(1) + key) * ld + 8 * c; kreg1 = *(const u32x4*)(Kg + off); vreg1 = *(const u32x4*)(Vg + off); }
    for (int i = 0; i < ntiles; i += 2) {
        __syncthreads();
        store_kv_tile(shm, kreg0, vreg0, key, c);
        if (i + 1 < ntiles) store_kv_tile(shm + A_BUF1, kreg1, vreg1, key, c);
        __syncthreads();
        if (i + 2 < ntiles) { const size_t off = (size_t)(tileRow(i + 2) + key) * ld + 8 * c; kreg0 = *(const u32x4*)(Kg + off); vreg0 = *(const u32x4*)(Vg + off); }
        if (i + 3 < ntiles) { const size_t off = (size_t)(tileRow(i + 3) + key) * ld + 8 * c; kreg1 = *(const u32x4*)(Kg + off); vreg1 = *(const u32x4*)(Vg + off); }
#pragma unroll 1
        for (int u = 0; u < 2; ++u) {
            const int ti = i + u; if (ti >= ntiles) break;
            LAS unsigned char* tb = shm + u * A_BUF1;
            int lo, hi; maskAt(ti, lo, hi);
            if (__all((hi < 0) || (lo > 63) || (hi < lo))) continue;
            const bool full = __all((lo <= 0) && (hi >= 63));
            f32x16 s[2]; qk_tile(tb + A_KS, q, r, h, s);
            if (MODE == 0) { if (full) softmax_update<true>(s, lo, hi, h, m, l, o); else softmax_update<false>(s, lo, hi, h, m, l, o); pv_tile(tb + A_VTS, 0, s, r, h, o); }
            else if (MODE == 1) { f32x16 dummy[2]; dummy[0] = zero16(); dummy[1] = zero16(); if (full) softmax_update<true>(s, lo, hi, h, m, l, dummy); else softmax_update<false>(s, lo, hi, h, m, l, dummy); }
            else {
#pragma unroll
                for (int kt = 0; kt < 2; ++kt)
#pragma unroll
                    for (int g = 0; g < 4; ++g) { float sum4 = 0.f, p3 = 0.f;
#pragma unroll
                        for (int e = 0; e < 4; ++e) { const int reg = 4 * g + e, kl = 32 * kt + 8 * g + 4 * h + e; const bool v = (kl >= lo) && (kl <= hi);
                            const float p = v ? fast_exp2(s[kt][reg] - m) * inv : 0.f; s[kt][reg] = p; sum4 += p; p3 = p; }
                        const int j = 16 * ti + 8 * kt + 2 * g + h;
                        __hip_atomic_fetch_add(imp + qloc * 65 + j, sum4, __ATOMIC_RELAXED, __HIP_MEMORY_SCOPE_WORKGROUP);
                        if (j + 1 < 64) __hip_atomic_fetch_add(imp + qloc * 65 + j + 1, p3, __ATOMIC_RELAXED, __HIP_MEMORY_SCOPE_WORKGROUP); }
                pv_tile(tb + A_VTS, 0, s, r, h, o);
            }
        }
    }
}

__device__ __forceinline__ void swa_item(const Params& P, int l, int it, LAS unsigned char* shm, int wv__) {
    const int tid = opaque_tid(wv__), lane = tid & 63, w = tid >> 6, r = lane & 31, h = lane >> 5;
    const int b = it >> 6, kvh = (it >> 5) & 1, qt = it & 31;
    const bf16_t* p = (const bf16_t*)(P.ws + WS_R1) + (size_t)b * S_ * LDP; const f32x2* rope = (const f32x2*)(P.ws + WS_MISC + X_ROPE);
    const int g = w >> 2, qsub = w & 3, head = 2 * kvh + g, qpos = 128 * qt + 32 * qsub + r;
    QF q; load_q(q, p + (size_t)qpos * LDP + C_SWAQ + 64 * head, h, rope + (size_t)qpos * 32, 0.125f * LOG2E);
    float m = P.in[I_SINK][l * 4 + head] * LOG2E, lsum = (h == 0) ? 1.f : 0.f; f32x16 o[2]; o[0] = zero16(); o[1] = zero16();
    const int j0 = (qt == 0) ? 0 : 2 * qt - 2, nt = 2 * qt + 2 - j0;
    flash_loop<0>(nt, [&](int i) { return 64 * (j0 + i); }, [&](int i, int& lo, int& hi) { const int tb = 64 * (j0 + i); lo = qpos - 127 - tb; hi = qpos - tb; },
                  p + C_SWAK + 64 * kvh, p + C_SWAV + 64 * kvh, LDP, q, m, lsum, o, shm, tid, lane);
    lsum += __shfl_xor(lsum, 32); const float inv = 1.0f / lsum;
    bf16_t* y = (bf16_t*)(P.ws + WS_Y + Y_SWA) + ((size_t)b * S_ + qpos) * 256 + 64 * head;
#pragma unroll
    for (int dt = 0; dt < 2; ++dt)
#pragma unroll
        for (int gg = 0; gg < 4; ++gg) { const f32x16& a = o[dt]; *(u32x2*)(y + 32 * dt + 8 * gg + 4 * h) = (u32x2){cvt_pk_bf16(a[4 * gg] * inv, a[4 * gg + 1] * inv), cvt_pk_bf16(a[4 * gg + 2] * inv, a[4 * gg + 3] * inv)}; }
}

__device__ __forceinline__ void nsa_cmp_item(const Params& P, int it, LAS unsigned char* shm, int wv__) {
    const int tid = opaque_tid(wv__), lane = tid & 63, w = tid >> 6, r = lane & 31, h = lane >> 5;
    const int b = it >> 6, qt = it & 63, q0 = 64 * qt;
    const bf16_t* p = (const bf16_t*)(P.ws + WS_R1) + (size_t)b * S_ * LDP;
    const bf16_t* kc = (const bf16_t*)(P.ws + WS_Z3 + M_KC) + (size_t)b * 256 * 64; const bf16_t* vc = (const bf16_t*)(P.ws + WS_Z3 + M_VC) + (size_t)b * 256 * 64;
    LAS float* imp = (LAS float*)(shm + A_MISC);
    for (int e = tid; e < 64 * 65; e += 512) imp[e] = 0.f;
    const int hd = w >> 1, qsub = w & 1, qloc = 32 * qsub + r, qpos = q0 + qloc;
    QF q; load_q(q, p + (size_t)qpos * LDP + C_NSAQ + 64 * hd, h, nullptr, 0.125f * LOG2E);
    const int nmax = (qpos - 31) >> 4, nml = (q0 + 63 - 31) >> 4, nt = nml < 0 ? 0 : (nml >> 6) + 1;
    float m = -1e30f, lsum = 0.f; f32x16 o[2]; o[0] = zero16(); o[1] = zero16();
    auto tr = [&](int i) { return 64 * i; }; auto mk = [&](int i, int& lo, int& hi) { lo = 0; hi = nmax - 64 * i; };
    flash_loop<1>(nt, tr, mk, kc, vc, 64, q, m, lsum, o, shm, tid, lane);
    lsum += __shfl_xor(lsum, 32); const float inv = lsum > 0.f ? 1.0f / lsum : 0.f;
    flash_loop<2>(nt, tr, mk, kc, vc, 64, q, m, lsum, o, shm, tid, lane, inv, imp, qloc);
    const float g0 = sigmoidf_(bf2f(p[(size_t)qpos * LDP + C_NGATE + hd * 3 + 0]));
    bf16_t* y = (bf16_t*)(P.ws + WS_Y + Y_NSA) + ((size_t)b * S_ + qpos) * 256 + 64 * hd;
#pragma unroll
    for (int dt = 0; dt < 2; ++dt)
#pragma unroll
        for (int gg = 0; gg < 4; ++gg) { const f32x16& a = o[dt]; *(u32x2*)(y + 32 * dt + 8 * gg + 4 * h) = (u32x2){cvt_pk_bf16(a[4 * gg] * g0, a[4 * gg + 1] * g0), cvt_pk_bf16(a[4 * gg + 2] * g0, a[4 * gg + 3] * g0)}; }
    __syncthreads();
    LAS float* scr = (LAS float*)(shm + A_MISC + 20480) + w * 64; unsigned long long* selm = (unsigned long long*)(P.ws + WS_Z3 + M_SEL) + (size_t)b * S_ + q0;
    const int cur = qt, j = lane;
    for (int qq = 8 * w; qq < 8 * w + 8; ++qq) {
        const bool forced = (j == 0) || (j == cur) || (j == cur - 1), valid = j <= cur;
        const float sc = forced ? 1e9f : (valid ? imp[qq * 65 + j] : -1e9f);
        scr[j] = sc; int rank = 0;
        for (int i = 0; i < 64; ++i) { const float si = scr[i]; rank += (si > sc || (si == sc && i < j)) ? 1 : 0; }
        const unsigned long long msk = __ballot(valid && rank < 16);
        if (lane == 0) selm[qq] = msk;
    }
    __syncthreads();
}

__device__ __forceinline__ void nsa_selwin_item(const Params& P, int it, LAS unsigned char* shm, int wv__) {
    const int tid = opaque_tid(wv__), lane = tid & 63, w = tid >> 6, r = lane & 31, h = lane >> 5;
    const int b = it & 7, qt = 63 - (it >> 3), q0 = 64 * qt;
    const bf16_t* p = (const bf16_t*)(P.ws + WS_R1) + (size_t)b * S_ * LDP; const f32x2* rope = (const f32x2*)(P.ws + WS_MISC + X_ROPE);
    const unsigned long long* selm = (const unsigned long long*)(P.ws + WS_Z3 + M_SEL) + (size_t)b * S_ + q0;
    const int hd = w >> 1, qsub = w & 1, qloc = 32 * qsub + r, qpos = q0 + qloc;
    LAS int* list = (LAS int*)(shm + A_MISC);
    unsigned long long un = selm[lane];
#pragma unroll
    for (int off = 1; off < 64; off <<= 1) { const unsigned lo = __shfl_xor((unsigned)un, off), hi = __shfl_xor((unsigned)(un >> 32), off); un |= ((unsigned long long)hi << 32) | lo; }
    const int nsel = __popcll(un);
    __syncthreads();
    if (tid == 0) { unsigned long long u = un; int k = 0; while (u) { list[k++] = __ffsll((long long)u) - 1; u &= u - 1; } }
    __syncthreads();
    const unsigned long long mysel = selm[qloc];
    QF q; load_q(q, p + (size_t)qpos * LDP + C_NSAQ + 64 * hd, h, rope + (size_t)qpos * 32, 0.125f * LOG2E);
    const float g1 = sigmoidf_(bf2f(p[(size_t)qpos * LDP + C_NGATE + hd * 3 + 1])), g2 = sigmoidf_(bf2f(p[(size_t)qpos * LDP + C_NGATE + hd * 3 + 2]));
    bf16_t* y = (bf16_t*)(P.ws + WS_Y + Y_NSA) + ((size_t)b * S_ + qpos) * 256 + 64 * hd;
    auto accum = [&](const f32x16 (&o)[2], float inv) {
#pragma unroll
        for (int dt = 0; dt < 2; ++dt)
#pragma unroll
            for (int gg = 0; gg < 4; ++gg) { u32x2* yp = (u32x2*)(y + 32 * dt + 8 * gg + 4 * h); const u32x2 c = *yp; const f32x16& a = o[dt];
                *yp = (u32x2){cvt_pk_bf16(a[4 * gg] * inv + bf_lo(c.x), a[4 * gg + 1] * inv + bf_hi(c.x)), cvt_pk_bf16(a[4 * gg + 2] * inv + bf_lo(c.y), a[4 * gg + 3] * inv + bf_hi(c.y))}; } };
    {
        float m = -1e30f, lsum = 0.f; f32x16 o[2]; o[0] = zero16(); o[1] = zero16();
        flash_loop<0>(nsel, [&](int i) { return 64 * list[i]; },
                      [&](int i, int& lo, int& hi) { const int j = list[i]; lo = 0; hi = ((mysel >> j) & 1ull) ? (qpos - 64 * j) : -1; },
                      p + C_KSLC, p + C_VSLC, LDP, q, m, lsum, o, shm, tid, lane);
        lsum += __shfl_xor(lsum, 32); accum(o, lsum > 0.f ? g1 / lsum : 0.f);
    }
    {
        float m = -1e30f, lsum = 0.f; f32x16 o[2]; o[0] = zero16(); o[1] = zero16();
        const int j0 = qt >= 8 ? qt - 8 : 0, nt = qt - j0 + 1;
        flash_loop<0>(nt, [&](int i) { return 64 * (j0 + i); }, [&](int i, int& lo, int& hi) { const int tb = 64 * (j0 + i); lo = qpos - 511 - tb; hi = qpos - tb; },
                      p + C_KWIN, p + C_VWIN, LDP, q, m, lsum, o, shm, tid, lane);
        lsum += __shfl_xor(lsum, 32); accum(o, g2 / lsum);
    }
    __syncthreads();
}

__device__ __forceinline__ float ret_log2g(int hd) { return log2f(1.0f - exp2f(-5.0f - (float)hd)); }
__device__ __forceinline__ void ret_kv_item(const Params& P, int it, LAS unsigned char* shm, int wv__) {
    const int tid = opaque_tid(wv__), lane = tid & 63, w = tid >> 6, r = lane & 31, h = lane >> 5;
    const int n = it & 31, hd = (it >> 5) & 3, b = it >> 7;
    const bf16_t* p = (const bf16_t*)(P.ws + WS_R1) + ((size_t)b * S_ + 128 * n) * LDP;
    LAS bf16_t* Kt = (LAS bf16_t*)shm; LAS bf16_t* Vt = (LAS bf16_t*)(shm + 17408);
    const float l2g = ret_log2g(hd);
    __syncthreads();
#pragma unroll
    for (int i = 0; i < 2; ++i) { const int task = tid + 512 * i, tok = task >> 3, c = task & 7; const u32x4 wv = *(const u32x4*)(p + (size_t)tok * LDP + C_RETK + 64 * hd + 8 * c);
        const float z = fast_exp2(l2g * (float)(127 - tok)); const unsigned ww[4] = {wv.x, wv.y, wv.z, wv.w}; LAS bf16_t* kt = Kt + (8 * c) * 136 + tok;
#pragma unroll
        for (int e = 0; e < 4; ++e) { const unsigned pk = cvt_pk_bf16(bf_lo(ww[e]) * z, bf_hi(ww[e]) * z); kt[(2 * e) * 136] = (bf16_t)(pk & 0xffff); kt[(2 * e + 1) * 136] = (bf16_t)(pk >> 16); } }
#pragma unroll
    for (int i = 0; i < 4; ++i) { const int task = tid + 512 * i, tok = task >> 4, c = task & 15; const u32x4 wv = *(const u32x4*)(p + (size_t)tok * LDP + C_RETV + 128 * hd + 8 * c);
        const unsigned ww[4] = {wv.x, wv.y, wv.z, wv.w}; LAS bf16_t* vt = Vt + (8 * c) * 136 + tok;
#pragma unroll
        for (int e = 0; e < 4; ++e) { vt[(2 * e) * 136] = (bf16_t)(ww[e] & 0xffff); vt[(2 * e + 1) * 136] = (bf16_t)(ww[e] >> 16); } }
    __syncthreads();
    const int et = w >> 1, dtile = w & 1; f32x16 acc = zero16();
#pragma unroll
    for (int s = 0; s < 8; ++s) { const bf16x8 a = *(const LAS bf16x8*)(Vt + (32 * et + r) * 136 + 16 * s + 8 * h), bb = *(const LAS bf16x8*)(Kt + (32 * dtile + r) * 136 + 16 * s + 8 * h); acc = mfma32(a, bb, acc); }
    bf16_t* kv = (bf16_t*)(P.ws + WS_Z3 + M_KV) + (size_t)it * 8192;
#pragma unroll
    for (int reg = 0; reg < 16; ++reg) { const int e = 32 * et + (reg & 3) + 8 * (reg >> 2) + 4 * h; kv[e * 64 + 32 * dtile + r] = (bf16_t)(cvt_pk_bf16(acc[reg], 0.f) & 0xffff); }
}

__device__ __forceinline__ void ret_out_item(const Params& P, int l, int it, LAS unsigned char* shm, int wv__) {
    const int tid = opaque_tid(wv__), lane = tid & 63, w = tid >> 6, r = lane & 31, h = lane >> 5;
    const int n = it & 31, hd = (it >> 5) & 3, b = it >> 7;
    const bf16_t* p = (const bf16_t*)(P.ws + WS_R1) + ((size_t)b * S_ + 128 * n) * LDP; const f32x2* rope = (const f32x2*)(P.ws + WS_MISC + X_ROPE);
    LAS bf16_t* Rt = (LAS bf16_t*)(shm + A_MISC); LAS f32x2* part = (LAS f32x2*)(shm + A_MISC + 18432);
    const float l2g = ret_log2g(hd), gch = fast_exp2(l2g * 128.0f);
    const int key = tid >> 3, c = tid & 7;
    u32x4 tk[2], tv0[2], tv1[2];
#pragma unroll
    for (int kt2 = 0; kt2 < 2; ++kt2) { const size_t off = (size_t)(64 * kt2 + key) * LDP;
        tk[kt2] = *(const u32x4*)(p + off + C_RETK + 64 * hd + 8 * c); tv0[kt2] = *(const u32x4*)(p + off + C_RETV + 128 * hd + 8 * c); tv1[kt2] = *(const u32x4*)(p + off + C_RETV + 128 * hd + 64 + 8 * c); }
    __syncthreads();
    {
        const bf16_t* kv = (const bf16_t*)(P.ws + WS_Z3 + M_KV) + (size_t)(it - n) * 8192 + tid * 16; f32x4 a[4];
#pragma unroll
        for (int i = 0; i < 4; ++i) a[i] = (f32x4){0.f, 0.f, 0.f, 0.f};
#pragma unroll 8
        for (int j = 0; j < n; ++j) { const u32x4* s = (const u32x4*)(kv + (size_t)j * 8192); const u32x4 s0 = s[0], s1 = s[1];
            a[0] = a[0] * gch + (f32x4){bf_lo(s0.x), bf_hi(s0.x), bf_lo(s0.y), bf_hi(s0.y)}; a[1] = a[1] * gch + (f32x4){bf_lo(s0.z), bf_hi(s0.z), bf_lo(s0.w), bf_hi(s0.w)};
            a[2] = a[2] * gch + (f32x4){bf_lo(s1.x), bf_hi(s1.x), bf_lo(s1.y), bf_hi(s1.y)}; a[3] = a[3] * gch + (f32x4){bf_lo(s1.z), bf_hi(s1.z), bf_lo(s1.w), bf_hi(s1.w)}; }
        const int e = tid >> 2, d0 = (tid & 3) * 16; LAS u32x4* dst = (LAS u32x4*)(Rt + e * 72 + d0);
        dst[0] = (u32x4){cvt_pk_bf16(a[0][0], a[0][1]), cvt_pk_bf16(a[0][2], a[0][3]), cvt_pk_bf16(a[1][0], a[1][1]), cvt_pk_bf16(a[1][2], a[1][3])};
        dst[1] = (u32x4){cvt_pk_bf16(a[2][0], a[2][1]), cvt_pk_bf16(a[2][2], a[2][3]), cvt_pk_bf16(a[3][0], a[3][1]), cvt_pk_bf16(a[3][2], a[3][3])};
    }
    const int qsub = w & 3, eh = w >> 2, qc = 32 * qsub + r, qpos = 128 * n + qc;
    QF q; load_q(q, p + (size_t)qc * LDP + C_RETQ + 64 * hd, h, rope + (size_t)qpos * 32, 0.125f);
    __syncthreads();
    f32x16 o[2];
#pragma unroll
    for (int dt = 0; dt < 2; ++dt) { o[dt] = zero16();
#pragma unroll
        for (int ks = 0; ks < 4; ++ks) { const bf16x8 a = *(const LAS bf16x8*)(Rt + (64 * eh + 32 * dt + r) * 72 + 16 * ks + 8 * h); o[dt] = mfma32(a, q.f[ks], o[dt]); }
        o[dt] = o[dt] * fast_exp2(l2g * (float)(qc + 1)); }
#pragma unroll
    for (int kt2 = 0; kt2 < 2; ++kt2) {
        const u32x4 kreg = tk[kt2], v0 = tv0[kt2], v1 = tv1[kt2];
        __syncthreads();
        store_kv_tile(shm, kreg, v0, key, c);
        { LAS bf16_t* vt = (LAS bf16_t*)(shm + A_VTS) + (64 + 8 * c) * 68 + key;
          vt[0] = (bf16_t)(v1.x & 0xffff); vt[68] = (bf16_t)(v1.x >> 16); vt[136] = (bf16_t)(v1.y & 0xffff); vt[204] = (bf16_t)(v1.y >> 16);
          vt[272] = (bf16_t)(v1.z & 0xffff); vt[340] = (bf16_t)(v1.z >> 16); vt[408] = (bf16_t)(v1.w & 0xffff); vt[476] = (bf16_t)(v1.w >> 16); }
        __syncthreads();
        if (64 * kt2 <= 32 * qsub + 31) {
            f32x16 s[2]; qk_tile(shm + A_KS, q, r, h, s);
#pragma unroll
            for (int kt = 0; kt < 2; ++kt)
#pragma unroll
                for (int reg = 0; reg < 16; ++reg) { const int kc_ = 64 * kt2 + 32 * kt + (reg & 3) + 8 * (reg >> 2) + 4 * h, diff = qc - kc_;
                    s[kt][reg] = diff >= 0 ? s[kt][reg] * fast_exp2(l2g * (float)diff) : 0.f; }
            pv_tile(shm + A_VTS, 64 * eh, s, r, h, o);
        }
    }
    float s1 = 0.f, s2 = 0.f;
#pragma unroll
    for (int dt = 0; dt < 2; ++dt)
#pragma unroll
        for (int e = 0; e < 16; ++e) { s1 += o[dt][e]; s2 += o[dt][e] * o[dt][e]; }
    s1 += __shfl_xor(s1, 32); s2 += __shfl_xor(s2, 32);
    if (h == 0) part[eh * 128 + qc] = (f32x2){s1, s2};
    __syncthreads();
    const f32x2 pa = part[qc], pb = part[128 + qc];
    const float mean = (pa.x + pb.x) * (1.0f / 128.0f), var = (pa.y + pb.y) * (1.0f / 128.0f) - mean * mean, rstd = rsqrtf(fmaxf(var, 0.f) + 1e-5f);
    const float* gn = P.in[I_GNG] + (size_t)l * 512 + 128 * hd;
    bf16_t* y = (bf16_t*)(P.ws + WS_Y + Y_RET) + ((size_t)b * S_ + qpos) * 512 + 128 * hd;
    const bf16_t* gin = p + (size_t)qc * LDP + C_RETG + 128 * hd;
#pragma unroll
    for (int dt = 0; dt < 2; ++dt)
#pragma unroll
        for (int gg = 0; gg < 4; ++gg) { const int e = 64 * eh + 32 * dt + 8 * gg + 4 * h; const f32x4 g4 = *(const f32x4*)(gn + e); const u32x2 gi = *(const u32x2*)(gin + e);
            const float gv[4] = {bf_lo(gi.x), bf_hi(gi.x), bf_lo(gi.y), bf_hi(gi.y)}; float ov[4];
#pragma unroll
            for (int i = 0; i < 4; ++i) { const float on = (o[dt][4 * gg + i] - mean) * rstd * g4[i]; ov[i] = gv[i] * sigmoidf_(gv[i]) * on; }
            *(u32x2*)(y + e) = (u32x2){cvt_pk_bf16(ov[0], ov[1]), cvt_pk_bf16(ov[2], ov[3])}; }
    __syncthreads();
}

template <int CTRL> __device__ __forceinline__ float dpp_add(float x) { return x + __builtin_bit_cast(float, __builtin_amdgcn_update_dpp(0, __builtin_bit_cast(int, x), CTRL, 0xf, 0xf, true)); }
__device__ __forceinline__ float reduce8(float x) { x = dpp_add<0xB1>(x); x = dpp_add<0x4E>(x); x = dpp_add<0x141>(x); return x; }
__device__ __forceinline__ float reduce16(float x) { x = reduce8(x); x = dpp_add<0x140>(x); return x; }
constexpr int R_R = 0, R_K = 8192, R_W = 16384, R_KK = 24576, R_KKA = 32768, R_A = 40960, R_VP = 49152, R_GP = 53248, R_YP = 57344, R_RK = 61440, R_ST = 61696,
              R_TW = 62720, R_AL = 67328, R_GL = 71936, R_W2 = 80640, R_A2 = 89856, R_G2 = 99072, R_END = 107776, R_V3X = 107776, R_RK2X = 113920;
__device__ __forceinline__ void rwkv_item(const Params& P, int l, int it, LAS unsigned char* shm, int wv__) {
    const int tid = opaque_tid(wv__), lane = tid & 63, w = tid >> 6, r = lane & 31, h = lane >> 5;
    const int chain = it >> 2, part = it & 3, b = chain >> 2, hd = chain & 3;
    const bf16_t* p = (const bf16_t*)(P.ws + WS_R1) + (size_t)b * S_ * LDP + C_RWKV;
    const float* mu = P.in[I_MU] + (size_t)l * 1024;
    LAS float* sR = (LAS float*)(shm + R_R); LAS float* sK = (LAS float*)(shm + R_K); LAS float* sW = (LAS float*)(shm + R_W);
    LAS float* sA = (LAS float*)(shm + R_A); LAS float* sKK = (LAS float*)(shm + R_KK); LAS float* sKKA = (LAS float*)(shm + R_KKA);
    LAS float* sVp = (LAS float*)(shm + R_VP); LAS float* sGp = (LAS float*)(shm + R_GP); LAS float* sYp = (LAS float*)(shm + R_YP);
    LAS float* sRK = (LAS float*)(shm + R_RK); LAS float* sST = (LAS float*)(shm + R_ST);
    LAS bf16_t* sTW = (LAS bf16_t*)(shm + R_TW); LAS bf16_t* sAL = (LAS bf16_t*)(shm + R_AL); LAS bf16_t* sGL = (LAS bf16_t*)(shm + R_GL);
    LAS bf16_t* W2t = (LAS bf16_t*)(shm + R_W2); LAS bf16_t* A2t = (LAS bf16_t*)(shm + R_A2); LAS bf16_t* G2t = (LAS bf16_t*)(shm + R_G2);
    __syncthreads();
    {
        const float* w2 = P.in[I_W2] + (size_t)l * 64 * 256 + 64 * hd; const float* a2 = P.in[I_A2] + (size_t)l * 64 * 256 + 64 * hd; const float* g2 = P.in[I_G2] + (size_t)l * 128 * 256 + 64 * hd + 16 * part;
        for (int e = tid; e < 4096; e += 512) { const int k = e >> 6, n = e & 63; W2t[n * 72 + k] = (bf16_t)(cvt_pk_bf16(w2[k * 256 + n], 0.f) & 0xffff); A2t[n * 72 + k] = (bf16_t)(cvt_pk_bf16(a2[k * 256 + n], 0.f) & 0xffff); }
        for (int e = tid; e < 4096; e += 512) { const int k = e >> 5, n = e & 31; G2t[n * 136 + k] = n < 16 ? (bf16_t)(cvt_pk_bf16(g2[k * 256 + n], 0.f) & 0xffff) : (bf16_t)0; }
    }
    const int t4 = tid & 255;
    int tcol[13], ttok[13];
#pragma unroll
    for (int i = 0; i < 8; ++i) { ttok[i] = (t4 >> 4) + 16 * (i & 1); tcol[i] = (i < 2 ? 64 * hd : i < 4 ? 256 + 64 * hd : i < 6 ? 768 : 832) + 4 * (t4 & 15); }
#pragma unroll
    for (int i = 8; i < 12; ++i) { ttok[i] = (t4 >> 5) + 8 * (i - 8); tcol[i] = 896 + 4 * (t4 & 31); }
    ttok[12] = t4 < 128 ? (t4 >> 2) : -1; tcol[12] = 512 + 64 * hd + 16 * part + 4 * (t4 & 3);
    u32x2 cur[13], prv[13];
    auto issue = [&](int ch) {
#pragma unroll
        for (int i = 0; i < 13; ++i) { const int t = 32 * ch + ttok[i]; cur[i] = (u32x2){0u, 0u}; prv[i] = (u32x2){0u, 0u};
            if (ttok[i] >= 0) { cur[i] = *(const u32x2*)(p + (size_t)t * LDP + tcol[i]); if (t > 0) prv[i] = *(const u32x2*)(p + (size_t)(t - 1) * LDP + tcol[i]); } } };
    LAS float* sR2 = (LAS float*)(shm + R_RK2X); LAS float* sK2 = sR2 + 2048; LAS float* sV3 = (LAS float*)(shm + R_V3X);
    auto stage_a = [&](int ch) {
        LAS float* dR = (ch & 1) ? sR2 : sR; LAS float* dK = (ch & 1) ? sK2 : sK; LAS float* dV = sV3 + (ch % 3) * 512;
#pragma unroll
        for (int i = 0; i < 13; ++i) if (ttok[i] >= 0) { const int tt = ttok[i], col = tcol[i]; const f32x4 m4 = *(const f32x4*)(mu + col);
            const float c0 = bf_lo(cur[i].x), c1 = bf_hi(cur[i].x), c2 = bf_lo(cur[i].y), c3 = bf_hi(cur[i].y);
            const float x0 = c0 + m4[0] * (bf_lo(prv[i].x) - c0), x1 = c1 + m4[1] * (bf_hi(prv[i].x) - c1), x2 = c2 + m4[2] * (bf_lo(prv[i].y) - c2), x3 = c3 + m4[3] * (bf_hi(prv[i].y) - c3);
            if (i < 2) *(LAS f32x4*)(dR + tt * 64 + (col & 63)) = (f32x4){x0, x1, x2, x3};
            else if (i < 4) *(LAS f32x4*)(dK + tt * 64 + (col & 63)) = (f32x4){x0, x1, x2, x3};
            else if (i == 12) *(LAS f32x4*)(dV + tt * 16 + (col & 15)) = (f32x4){x0, x1, x2, x3};
            else if (i < 6) *(LAS u32x2*)(sTW + tt * 72 + (col - 768)) = (u32x2){cvt_pk_bf16(fast_tanh(x0), fast_tanh(x1)), cvt_pk_bf16(fast_tanh(x2), fast_tanh(x3))};
            else if (i < 8) *(LAS u32x2*)(sAL + tt * 72 + (col - 832)) = (u32x2){cvt_pk_bf16(x0, x1), cvt_pk_bf16(x2, x3)};
            else *(LAS u32x2*)(sGL + tt * 136 + (col - 896)) = (u32x2){cvt_pk_bf16(fast_sigmoid(x0), fast_sigmoid(x1)), cvt_pk_bf16(fast_sigmoid(x2), fast_sigmoid(x3))}; } };
    const float w0v = P.in[I_W0][(size_t)l * 256 + 64 * hd + 32 * (w & 1) + r], a0v = P.in[I_A0][(size_t)l * 256 + 64 * hd + 32 * (w & 1) + r];
    f32x2 st01 = (f32x2){0.f, 0.f}, st23 = (f32x2){0.f, 0.f};
    const int srow = 4 * w + (lane >> 4), scg = lane & 15;
    const int ptok = tid >> 4, pl = tid & 15, pc = pl * 4, hc = 64 * hd + pc;
    const f32x4 kk4 = *(const f32x4*)(P.in[I_KK] + (size_t)l * 256 + hc), ka4 = *(const f32x4*)(P.in[I_KA] + (size_t)l * 256 + hc), rk4 = *(const f32x4*)(P.in[I_RK] + (size_t)l * 256 + hc);
    const int och = 64 * hd + 16 * part + pl;
    const float lng = P.in[I_LNG][(size_t)l * 256 + och], lnb = P.in[I_LNB][(size_t)l * 256 + och];
    bf16_t* yout = (bf16_t*)(P.ws + WS_Y + Y_RWKV) + (size_t)b * S_ * 256 + och; bf16_t* a1out = (bf16_t*)(P.ws + WS_Z3 + M_A1) + (size_t)b * S_ * 256 + och; bf16_t* a2out = (bf16_t*)(P.ws + WS_Z3 + M_A2) + (size_t)b * S_ * 256 + och;
    auto stage_b = [&](int ch) {
        if (w < 5) { const int mat = w >> 1, ntile = w & 1; f32x16 c = zero16(); const int chn = 32 * ntile + r;
            if (mat == 0) {
#pragma unroll
                for (int ks = 0; ks < 4; ++ks) c = mfma32(*(const LAS bf16x8*)(sTW + r * 72 + 16 * ks + 8 * h), *(const LAS bf16x8*)(W2t + chn * 72 + 16 * ks + 8 * h), c);
#pragma unroll
                for (int reg = 0; reg < 16; ++reg) { const int tok = (reg & 3) + 8 * (reg >> 2) + 4 * h; sW[tok * 64 + chn] = w0v + c[reg]; }
            } else if (mat == 1) {
#pragma unroll
                for (int ks = 0; ks < 4; ++ks) c = mfma32(*(const LAS bf16x8*)(sAL + r * 72 + 16 * ks + 8 * h), *(const LAS bf16x8*)(A2t + chn * 72 + 16 * ks + 8 * h), c);
#pragma unroll
                for (int reg = 0; reg < 16; ++reg) { const int tok = (reg & 3) + 8 * (reg >> 2) + 4 * h; sA[tok * 64 + chn] = a0v + c[reg]; }
            } else {
#pragma unroll
                for (int ks = 0; ks < 8; ++ks) c = mfma32(*(const LAS bf16x8*)(sGL + r * 136 + 16 * ks + 8 * h), *(const LAS bf16x8*)(G2t + r * 136 + 16 * ks + 8 * h), c);
                if (r < 16) {
#pragma unroll
                    for (int reg = 0; reg < 16; ++reg) { const int tok = (reg & 3) + 8 * (reg >> 2) + 4 * h; sGp[(ch & 1) * 512 + tok * 16 + r] = c[reg]; } }
            } } };
    auto stage_c = [&](int ch) {
        LAS float* bR = (ch & 1) ? sR2 : sR; LAS float* bK = (ch & 1) ? sK2 : sK;
        const f32x4 k = *(const LAS f32x4*)(bK + ptok * 64 + pc), araw = *(const LAS f32x4*)(sA + ptok * 64 + pc), wraw = *(const LAS f32x4*)(sW + ptok * 64 + pc), rr = *(const LAS f32x4*)(bR + ptok * 64 + pc);
        f32x4 a, dec;
#pragma unroll
        for (int e = 0; e < 4; ++e) { a[e] = fast_sigmoid(araw[e]); dec[e] = __expf(-0.6065306597126334f * fast_sigmoid(wraw[e])); }
        *(LAS f32x4*)(sW + ptok * 64 + pc) = dec;
        const f32x4 kkv = k * kk4; float ss = (kkv[0] * kkv[0] + kkv[1] * kkv[1]) + (kkv[2] * kkv[2] + kkv[3] * kkv[3]); ss = reduce16(ss);
        const float inv = __builtin_amdgcn_rcpf(fmaxf(sqrtf(ss), 1e-12f)); const f32x4 kk = kkv * inv; const f32x4 kp = k * (1.0f + (a - 1.0f) * ka4);
        float rk = (rr[0] * kp[0] * rk4[0] + rr[1] * kp[1] * rk4[1]) + (rr[2] * kp[2] * rk4[2] + rr[3] * kp[3] * rk4[3]); rk = reduce16(rk);
        *(LAS f32x4*)(sKK + ptok * 64 + pc) = kk; *(LAS f32x4*)(sKKA + ptok * 64 + pc) = kk * a; *(LAS f32x4*)(bK + ptok * 64 + pc) = kp;
        if (pl == 0) sRK[(ch & 1) * 32 + ptok] = rk; };
    auto stage_e = [&](int ch) {
#pragma unroll
        for (int i = 0; i < 2; ++i) { const int tk = (t4 >> 4) + 16 * i, q = (t4 & 15);
            const float y = sYp[(ch & 1) * 512 + tk * 16 + q], vv = sV3[(ch % 3) * 512 + tk * 16 + q], g = sGp[(ch & 1) * 512 + tk * 16 + q], rk = sRK[(ch & 1) * 32 + tk]; const size_t o = (size_t)(32 * ch + tk) * 256;
            yout[o] = (bf16_t)(cvt_pk_bf16(y, 0.f) & 0xffff); a1out[o] = (bf16_t)(cvt_pk_bf16(lng * g, 0.f) & 0xffff); a2out[o] = (bf16_t)(cvt_pk_bf16((lnb + rk * vv) * g, 0.f) & 0xffff); } };
    const int NCH = S_ / 32;
    if (w >= 4) { issue(0); stage_a(0); issue(1); }
    __syncthreads();
    stage_b(0); __syncthreads(); stage_c(0); __syncthreads();
    for (int ch = 0; ch < NCH; ++ch) {
        if (w < 4) {
            const LAS float* cK = (ch & 1) ? sK2 : sK; const LAS float* cR = (ch & 1) ? sR2 : sR;
            const LAS float* bw = sW + 4 * scg; const LAS float* bk = sKK + 4 * scg; const LAS float* ba = sKKA + 4 * scg; const LAS float* bp = cK + 4 * scg; const LAS float* br = cR + 4 * scg;
            const LAS float* bv = sV3 + (ch % 3) * 512 + srow; LAS float* by = sYp + (ch & 1) * 512 + srow;
            f32x4 nw = *(const LAS f32x4*)bw, nk = *(const LAS f32x4*)bk, na = *(const LAS f32x4*)ba, np = *(const LAS f32x4*)bp, nr = *(const LAS f32x4*)br; float nv = bv[0];
#pragma unroll 8
            for (int tt = 0; tt < 32; ++tt) {
                const f32x4 w4 = nw, k4 = nk, a4 = na, p4 = np, r4 = nr; const float v = nv;
                if (tt + 1 < 32) { const int o = (tt + 1) * 64; nw = *(const LAS f32x4*)(bw + o); nk = *(const LAS f32x4*)(bk + o); na = *(const LAS f32x4*)(ba + o); np = *(const LAS f32x4*)(bp + o); nr = *(const LAS f32x4*)(br + o); nv = bv[(tt + 1) * 16]; }
                f32x2 d = st01 * (f32x2){k4[0], k4[1]}; d = st23 * (f32x2){k4[2], k4[3]} + d;
                f32x2 u01 = st01 * (f32x2){w4[0], w4[1]} + (f32x2){p4[0], p4[1]} * v, u23 = st23 * (f32x2){w4[2], w4[3]} + (f32x2){p4[2], p4[3]} * v;
                const float sa = -reduce16(d.x + d.y);
                st01 = (f32x2){a4[0], a4[1]} * sa + u01; st23 = (f32x2){a4[2], a4[3]} * sa + u23;
                f32x2 yy = st01 * (f32x2){r4[0], r4[1]}; yy = st23 * (f32x2){r4[2], r4[3]} + yy;
                const float y = reduce16(yy.x + yy.y);
                if (scg == 0) by[tt * 16] = y;
            }
        } else {
            if (ch >= 1) stage_e(ch - 1);
            if (ch + 1 < NCH) { stage_a(ch + 1); if (ch + 2 < NCH) issue(ch + 2); }
        }
        __syncthreads();
        if (ch + 1 < NCH) { stage_b(ch + 1); __syncthreads(); stage_c(ch + 1); __syncthreads(); }
    }
    if (w >= 4) stage_e(NCH - 1);
    __syncthreads();
}

constexpr int LDS_BYTES = 147456, L_ITEM = 140000;
__device__ __forceinline__ void phase_cmp2(const Params& P, int l, int bid, int nb, int wv__) {
    const int ctid = opaque_tid(wv__);
    for (int o = bid * 512 + ctid; o < 2 * 2048 * 64; o += nb * 512) {
        const int kv = o >> 17, m = (o >> 6) & 2047, j = o & 63;
        const bf16_t* hrow = (const bf16_t*)(P.ws + WS_Z3 + (kv ? M_H1V : M_H1K)) + (size_t)m * 256;
        const float* w2 = P.in[kv ? I_CVW2 : I_CKW2] + (size_t)l * 256 * 64 + j; float s = 0.f;
#pragma unroll 4
        for (int i = 0; i < 256; i += 8) { const u32x4 hv = *(const u32x4*)(hrow + i); const unsigned ww[4] = {hv.x, hv.y, hv.z, hv.w};
#pragma unroll
            for (int e = 0; e < 4; ++e) { s += bf_lo(ww[e]) * w2[(size_t)(i + 2 * e) * 64]; s += bf_hi(ww[e]) * w2[(size_t)(i + 2 * e + 1) * 64]; } }
        ((bf16_t*)(P.ws + WS_Z3 + (kv ? M_VC : M_KC)))[(size_t)m * 64 + j] = (bf16_t)(cvt_pk_bf16(s, 0.f) & 0xffff);
    }
}


#ifdef PROF_SEL
#define STAMP(cat) do { if (bid == 0 && opaque_tid(wv__) == 0) { const long long now_ = wall_clock64(); LAS long long* pa_ = (LAS long long*)(shm + 141000); pa_[cat] += now_ - pa_[7]; pa_[7] = now_; } } while (0)
#else
#define STAMP(cat) do {} while (0)
#endif
__device__ __forceinline__ void phase_rwkv_ln(const Params& P, int bid, int nb, int wv__) {
    const int tid = opaque_tid(wv__);
    bf16_t* y = (bf16_t*)(P.ws + WS_Y + Y_RWKV); const bf16_t* a1 = (const bf16_t*)(P.ws + WS_Z3 + M_A1); const bf16_t* a2 = (const bf16_t*)(P.ws + WS_Z3 + M_A2);
    const int gs = nb * 512; int g = bid * 512 + tid;
    u32x2 nyw = (u32x2){0u, 0u}, np1 = nyw, np2 = nyw;
    if (g < T_ * 64) { const size_t o = (size_t)g * 4; nyw = *(const u32x2*)(y + o); np1 = *(const u32x2*)(a1 + o); np2 = *(const u32x2*)(a2 + o); }
    for (; g < T_ * 64; g += gs) {
        const size_t o = (size_t)g * 4; const u32x2 yw = nyw, p1 = np1, p2 = np2;
        if (g + gs < T_ * 64) { const size_t on = (size_t)(g + gs) * 4; nyw = *(const u32x2*)(y + on); np1 = *(const u32x2*)(a1 + on); np2 = *(const u32x2*)(a2 + on); }
        const float y0 = bf_lo(yw.x), y1 = bf_hi(yw.x), y2 = bf_lo(yw.y), y3 = bf_hi(yw.y);
        const float mean = reduce16((y0 + y1) + (y2 + y3)) * (1.0f / 64.0f); const float d0 = y0 - mean, d1 = y1 - mean, d2 = y2 - mean, d3 = y3 - mean;
        const float rstd = rsqrtf(reduce16((d0 * d0 + d1 * d1) + (d2 * d2 + d3 * d3)) * (1.0f / 64.0f) + 64e-5f);
        *(u32x2*)(y + o) = (u32x2){cvt_pk_bf16(d0 * rstd * bf_lo(p1.x) + bf_lo(p2.x), d1 * rstd * bf_hi(p1.x) + bf_hi(p2.x)), cvt_pk_bf16(d2 * rstd * bf_lo(p1.y) + bf_lo(p2.y), d3 * rstd * bf_hi(p1.y) + bf_hi(p2.y))};
    }
}
__device__ __forceinline__ void sub_barrier(unsigned* c, unsigned target, bool arrive, int wv__) {
    __syncthreads();
    if (opaque_tid(wv__) == 0) {
        if (arrive) { __builtin_amdgcn_fence(__ATOMIC_RELEASE, "agent"); __hip_atomic_fetch_add(c, 1u, __ATOMIC_RELAXED, __HIP_MEMORY_SCOPE_AGENT); }
        while (__hip_atomic_load(c, __ATOMIC_RELAXED, __HIP_MEMORY_SCOPE_AGENT) < target) __builtin_amdgcn_s_sleep(1);
        __builtin_amdgcn_fence(__ATOMIC_ACQUIRE, "agent");
    }
    __syncthreads();
}
__device__ __forceinline__ void phase_cb_reduce(const Params& P, int wv__) {
    const int t = opaque_tid(wv__); const float* pp = (const float*)(P.ws + WS_MISC + X_CBP) + (t >> 8) * 32 * 256 + (t & 255); float sacc = 0.f;
#pragma unroll 8
    for (int c = 0; c < 32; ++c) sacc += pp[c * 256];
    ((float*)(P.ws + WS_MISC + X_CB))[t] = sacc;
}
__global__ void __launch_bounds__(512, 2) fwd_megakernel(Params P) {
    extern __shared__ __attribute__((aligned(16))) unsigned char shm_raw[];
    LAS unsigned char* shm = (LAS unsigned char*)shm_raw;
    cg::grid_group grid = cg::this_grid();
    const int bid = blockIdx.x, nb = gridDim.x, wv__ = __builtin_amdgcn_readfirstlane(threadIdx.x >> 6);
#define ws (opq_ptr(P.ws))
#define W ((bf16_t*)(ws + WS_W))
#define H ((bf16_t*)(ws + WS_H))
#define R1 ((bf16_t*)(ws + WS_R1))
#define Fb ((bf16_t*)(ws + WS_R1 + R1_F))
#define Yb ((bf16_t*)(ws + WS_Y))
#define Z3 ((bf16_t*)(ws + WS_Z3))
#define ctr ((unsigned*)(ws + WS_MISC + X_CTR))
#ifdef PROF_SEL
    if (bid == 0 && opaque_tid(wv__) == 0) { LAS long long* pa_ = (LAS long long*)(shm + 141000); pa_[0] = pa_[1] = pa_[2] = pa_[3] = pa_[4] = pa_[5] = 0; pa_[7] = wall_clock64(); }
#endif
    unsigned gk = 0;
#define GSYNC() sub_barrier(ctr + 9, (unsigned)nb * (++gk), true, wv__)
    if (nb > (1 << 24)) grid.sync();
    phase_rowpass(P.in[I_X], nullptr, nullptr, 0.f, nullptr, P.in[I_F1PRE], H, bid, nb, wv__);
    phase_convert(P, 0, shm, bid, nb, wv__);
    GSYNC(); STAMP(4);
    for (int l = 0; l < 2; ++l) {
        run_gemm(shm, H, DM, W + W_GU1, T_, 5632, DM, EpiSwiGLU{R1}, nb, bid, wv__);
        GSYNC(); STAMP(0);
        run_gemm(shm, R1, FF, W + W_D1, T_, DM, FF, EpiPlain{Fb, DM}, nb, bid, wv__);
        GSYNC(); STAMP(0);
        if (bid == nb - 1) phase_cb_reduce(P, wv__);
        phase_rowpass(l == 0 ? P.in[I_X] : P.out, Fb, P.in[I_F1POST] + (size_t)l * DM, 0.5f, P.out, P.in[I_MPRE] + (size_t)l * DM, H, bid, nb, wv__);
        GSYNC(); STAMP(4);
        run_gemm(shm, H, DM, W + W_IN, T_, LDP, DM, EpiWin{R1, (bf16_t*)(ws + WS_Z3 + M_KCIN), (bf16_t*)(ws + WS_Z3 + M_VCIN), (const f32x2*)(ws + WS_MISC + X_ROPE)}, nb, bid, wv__);
        GSYNC(); STAMP(0);
        {
            const int NR = 128, NWK = nb - NR, wb = bid - NR; unsigned* sbc = ctr + 8;
            if (bid < NR) {
                rwkv_item(P, l, bid, shm, wv__);
                STAMP(1);
                sub_barrier(sbc, (unsigned)(NWK * (3 * l + 3)), false, wv__);
            } else {
                if (wb < 8) run_gemm(shm, (const bf16_t*)(ws + WS_Z3 + M_KCIN), 1024, W + W_CK1, 2048, 256, 2048, EpiGelu{(bf16_t*)(ws + WS_Z3 + M_H1K), (const float*)(ws + WS_MISC + X_CB)}, 8, wb, wv__);
                else if (wb < 16) run_gemm(shm, (const bf16_t*)(ws + WS_Z3 + M_VCIN), 1024, W + W_CV1, 2048, 256, 2048, EpiGelu{(bf16_t*)(ws + WS_Z3 + M_H1V), (const float*)(ws + WS_MISC + X_CB) + 256}, 8, wb - 8, wv__);
                if (NWK == 128) { const int x = wb & 7, j = (wb >> 3) - 2;
                    if (j >= 0) { for (int i = j; i < 128; i += 14) ret_kv_item(P, x * 128 + i, shm, wv__);
                                  for (int i = j; i < 64; i += 14) swa_item(P, l, x * 64 + i, shm, wv__); }
                } else for (int it = wb; it < 1536; it += NWK) { if (it < 1024) ret_kv_item(P, it, shm, wv__); else swa_item(P, l, it - 1024, shm, wv__); }
                sub_barrier(sbc, (unsigned)(NWK * (3 * l + 1)), true, wv__);
                phase_cmp2(P, l, wb, NWK, wv__);
                sub_barrier(sbc, (unsigned)(NWK * (3 * l + 2)), true, wv__);
                if (NWK == 128) { const int x = wb & 7, j = wb >> 3; for (int k = 0; k < 4; ++k) nsa_cmp_item(P, x * 64 + j + 16 * k, shm, wv__); }
                else for (int it = wb; it < 512; it += NWK) nsa_cmp_item(P, it, shm, wv__);
                sub_barrier(sbc, (unsigned)(NWK * (3 * l + 3)), true, wv__);
            }
        }
        for (int sx = 0; sx < 8; ++sx) {
            const int x = (bid + sx) & 7;
            const bool t0 = opaque_tid(wv__) == 0; int nextv = 0;
            if (t0) nextv = (int)atomicAdd(ctr + 32 + l * 8 + x, 1u);
            for (;;) {
                __syncthreads();
                if (t0) *(LAS int*)(shm + L_ITEM) = nextv;
                __syncthreads();
                const int idx = *(LAS int*)(shm + L_ITEM);
                if (idx >= 192) break;
                if (t0) nextv = (int)atomicAdd(ctr + 32 + l * 8 + x, 1u);
                if (idx < 64) nsa_selwin_item(P, x + 8 * idx, shm, wv__); else ret_out_item(P, l, x * 128 + (idx - 64), shm, wv__);
            }
        }
        STAMP(2);
        GSYNC(); STAMP(3);
        phase_rwkv_ln(P, bid, nb, wv__);
        GSYNC(); STAMP(3);
        {
            const int g1 = nb / 5, g2 = g1 + 2 * (nb / 5), g3 = g2 + nb / 5;
            if (bid < g1) run_gemm(shm, Yb, 256, W + W_PNSA, T_, DM, 256, EpiPlain{R1, DM}, g1, bid, wv__);
            else if (bid < g2) run_gemm(shm, (const bf16_t*)(ws + WS_Y + Y_RET), 512, W + W_PRET, T_, DM, 512, EpiPlain{R1 + (size_t)T_ * DM, DM}, g2 - g1, bid - g1, wv__);
            else if (bid < g3) run_gemm(shm, (const bf16_t*)(ws + WS_Y + Y_RWKV), 256, W + W_PRWKV, T_, DM, 256, EpiPlain{R1 + (size_t)2 * T_ * DM, DM}, g3 - g2, bid - g2, wv__);
            else run_gemm(shm, (const bf16_t*)(ws + WS_Y + Y_SWA), 256, W + W_PSWA, T_, DM, 256, EpiPlain{Z3, DM}, nb - g3, bid - g3, wv__);
        }
        GSYNC(); STAMP(0);
        run_gemm(shm, H, DM, W + W_GATE, T_, 4096, DM, EpiMerge{{R1, R1 + (size_t)T_ * DM, R1 + (size_t)2 * T_ * DM, Z3}, Yb}, nb, bid, wv__, 1);
        GSYNC(); STAMP(0);
        run_gemm(shm, Yb, DM, W + W_OUT, T_, DM, DM, EpiPlain{Fb, DM}, nb, bid, wv__);
        GSYNC(); STAMP(0);
        phase_rowpass(P.out, Fb, P.in[I_MPOST] + (size_t)l * DM, 1.0f, P.out, P.in[I_F2PRE] + (size_t)l * DM, H, bid, nb, wv__);
        GSYNC(); STAMP(4);
        run_gemm(shm, H, DM, W + W_GU2, T_, 5632, DM, EpiSwiGLU{R1}, nb, bid, wv__);
        GSYNC(); STAMP(0);
        run_gemm(shm, R1, FF, W + W_D2, T_, DM, FF, EpiPlain{Fb, DM}, nb, bid, wv__);
        GSYNC(); STAMP(0);
        phase_rowpass(P.out, Fb, P.in[I_F2POST] + (size_t)l * DM, 0.5f, P.out, l == 0 ? P.in[I_F1PRE] + DM : nullptr, H, bid, nb, wv__);
        if (l == 0) phase_convert(P, 1, shm, bid, nb, wv__);
        GSYNC(); STAMP(4);
    }
#ifdef PROF_SEL
    if (bid == 0) { __syncthreads(); LAS long long* pa_ = (LAS long long*)(shm + 141000); const double tot = (double)(pa_[0] + pa_[1] + pa_[2] + pa_[3] + pa_[4] + pa_[5]);
        const int Kp = (PROF_SEL >= 6) ? 200000 : (int)(200000.0 * (double)pa_[PROF_SEL] / tot); for (int e = opaque_tid(wv__); e < Kp; e += 512) P.out[e] += 0.5f; }
#endif
}
#undef ws
#undef W
#undef H
#undef R1
#undef Fb
#undef Yb
#undef Z3
#undef ctr
#undef GSYNC

extern "C" void kernel_launch(void* const* d_in, const int* in_sizes, int n_in, void* d_out, int out_size, void* d_ws, size_t ws_size, hipStream_t stream) {
    static int grid_blocks = 0;
    if (grid_blocks == 0) {
        if (n_in != N_IN || out_size != T_ * DM || ws_size < WS_END) { fprintf(stderr, "kernel_launch: unexpected shapes (n_in %d out %d ws %zu)\n", n_in, out_size, ws_size); grid_blocks = -1; return; }
        int dev = 0, cus = 0, per_cu = 0;
        hipGetDevice(&dev); hipDeviceGetAttribute(&cus, hipDeviceAttributeMultiprocessorCount, dev);
        hipFuncSetAttribute((const void*)fwd_megakernel, hipFuncAttributeMaxDynamicSharedMemorySize, LDS_BYTES);
        hipOccupancyMaxActiveBlocksPerMultiprocessor(&per_cu, (const void*)fwd_megakernel, 512, LDS_BYTES);
        if (per_cu < 1) per_cu = 1;
        grid_blocks = cus * per_cu;
        if (grid_blocks < 160) { fprintf(stderr, "kernel_launch: needs >= 160 co-resident workgroups\n"); grid_blocks = -1; return; }
    }
    if (grid_blocks < 0) return;
    hipMemsetAsync((char*)d_ws + WS_MISC + X_CTR, 0, 256 + 128 * 64, stream);
#ifdef REP_IDX
    hipMemsetAsync((char*)d_ws + WS_MISC + X_CTR + 64 + REP_IDX, 1, 1, stream);
#endif
    Params p{};
    for (int i = 0; i < N_IN; ++i) p.in[i] = (const float*)d_in[i];
    p.out = (float*)d_out; p.ws = (unsigned char*)d_ws;
    void* args[] = {&p};
    hipError_t e = hipLaunchCooperativeKernel((const void*)fwd_megakernel, dim3(grid_blocks), dim3(512), args, LDS_BYTES, stream);
    if (e != hipSuccess) fprintf(stderr, "cooperative launch failed: %s (grid %d)\n", hipGetErrorString(e), grid_blocks);
}
```

```cpp
#include <hip/hip_runtime.h>
#include <hip/hip_cooperative_groups.h>
#include <cstdio>
namespace cg = cooperative_groups;

#define LAS __attribute__((address_space(3)))
typedef unsigned short bf16_t;
typedef short bf16x8 __attribute__((ext_vector_type(8)));
typedef float f32x2 __attribute__((ext_vector_type(2)));
typedef float f32x4 __attribute__((ext_vector_type(4)));
typedef float f32x16 __attribute__((ext_vector_type(16)));
typedef unsigned u32x2 __attribute__((ext_vector_type(2)));
typedef unsigned u32x4 __attribute__((ext_vector_type(4)));

constexpr int T_ = 32768, S_ = 4096, NB_ = 8, DM = 1024, FF = 2816, NCOL = 7820, LDP = 3840;
constexpr float LOG2E = 1.4426950408889634f;
constexpr int C_NSAQ = 0, C_KCMP = 256, C_VCMP = 320, C_KSLC = 384, C_VSLC = 448, C_KWIN = 512, C_VWIN = 576, C_NGATE = 640;
constexpr int C_RETQ = 704, C_RETK = 960, C_RETV = 1216, C_RETG = 1728, C_RWKV = 2240, C_SWAQ = 3264, C_SWAK = 3520, C_SWAV = 3648;

enum { I_X = 0, I_F1PRE, I_F1POST, I_F1G, I_F1U, I_F1D, I_MPRE, I_MPOST, I_WIN, I_POSK, I_POSV, I_CKW1, I_CKW2, I_CVW1, I_CVW2, I_GNG,
       I_MU, I_W0, I_W2, I_A0, I_A2, I_G2, I_KK, I_KA, I_RK, I_LNG, I_LNB, I_SINK, I_PNSA, I_PRET, I_PRWKV, I_PSWA, I_WOUT,
       I_F2PRE, I_F2POST, I_F2G, I_F2U, I_F2D, N_IN };

constexpr size_t MiB = 1048576;
constexpr size_t WS_W = 0, WS_H = 56 * MiB, WS_R1 = 120 * MiB, WS_Y = 360 * MiB, WS_Z3 = 440 * MiB, WS_MISC = 504 * MiB, WS_END = 510 * MiB;
constexpr size_t W_GU1 = 0, W_D1 = W_GU1 + (size_t)5632 * 1024, W_IN = W_D1 + (size_t)1024 * 2816, W_GATE = W_IN + (size_t)3840 * 1024,
                 W_PNSA = W_GATE + (size_t)4096 * 1024, W_PRET = W_PNSA + 262144, W_PRWKV = W_PRET + 524288, W_PSWA = W_PRWKV + 262144,
                 W_OUT = W_PSWA + 262144, W_GU2 = W_OUT + 1048576, W_D2 = W_GU2 + (size_t)5632 * 1024, W_CK1 = W_D2 + (size_t)1024 * 2816,
                 W_CV1 = W_CK1 + 524288, W_ENDE = W_CV1 + 524288;
static_assert(W_ENDE * 2 <= 56 * MiB, "weights");
constexpr size_t R1_F = (size_t)T_ * FF * 2;
constexpr size_t Y_NSA = 0, Y_RET = (size_t)T_ * 256 * 2, Y_RWKV = Y_RET + (size_t)T_ * 512 * 2, Y_SWA = Y_RWKV + (size_t)T_ * 256 * 2;
constexpr size_t M_KCIN = 0, M_VCIN = M_KCIN + ((size_t)T_ + 64) * 64 * 2, M_H1K = M_VCIN + ((size_t)T_ + 64) * 64 * 2, M_H1V = M_H1K + 2048 * 256 * 2,
                 M_KC = M_H1V + 2048 * 256 * 2, M_VC = M_KC + 2048 * 64 * 2, M_SEL = M_VC + 2048 * 64 * 2, M_KV = M_SEL + (size_t)T_ * 8,
                 M_A1 = M_KV + (size_t)1024 * 8192 * 2, M_A2 = M_A1 + (size_t)T_ * 256 * 2, M_END = M_A2 + (size_t)T_ * 256 * 2;
static_assert(M_END <= 64 * MiB, "mixer scratch");
constexpr size_t X_ROPE = 0, X_CB = X_ROPE + (size_t)S_ * 32 * 8, X_CTR = X_CB + 4096;
constexpr size_t X_FLAG = X_CTR + 256, X_XB = X_FLAG + 128 * 64, X_CBP = X_XB + 131072;

struct Params { const float* in[N_IN]; float* out; unsigned char* ws; };

typedef __bf16 bf16x2v __attribute__((ext_vector_type(2)));
__device__ __forceinline__ unsigned cvt_pk_bf16(float lo, float hi) { const f32x2 v = (f32x2){lo, hi}; const bf16x2v b = __builtin_convertvector(v, bf16x2v); return __builtin_bit_cast(unsigned, b); }
__device__ __forceinline__ float bf_lo(unsigned u) { return __uint_as_float(u << 16); }
__device__ __forceinline__ float bf_hi(unsigned u) { return __uint_as_float(u & 0xffff0000u); }
__device__ __forceinline__ float bf2f(bf16_t b) { return __uint_as_float(((unsigned)b) << 16); }
__device__ __forceinline__ float fast_exp2(float x) { return __builtin_amdgcn_exp2f(x); }
__device__ __forceinline__ float sigmoidf_(float x) { return __builtin_amdgcn_rcpf(1.0f + __builtin_amdgcn_exp2f(-1.4426950408889634f * x)); }
__device__ __forceinline__ float fast_sigmoid(float x) { return __builtin_amdgcn_rcpf(1.0f + __builtin_amdgcn_exp2f(-1.4426950408889634f * x)); }
__device__ __forceinline__ float fast_tanh(float x) { return 1.0f - 2.0f * __builtin_amdgcn_rcpf(1.0f + __builtin_amdgcn_exp2f(2.8853900817779268f * x)); }
template <int CTRL> __device__ __forceinline__ float dpp_add_(float x) { return x + __builtin_bit_cast(float, __builtin_amdgcn_update_dpp(0, __builtin_bit_cast(int, x), CTRL, 0xf, 0xf, true)); }
__device__ __forceinline__ float wave_sum(float v) {
    v = dpp_add_<0xB1>(v); v = dpp_add_<0x4E>(v); v = dpp_add_<0x141>(v); v = dpp_add_<0x140>(v);
    v += __shfl_xor(v, 16); v += __shfl_xor(v, 32);
    return v;
}
__device__ __forceinline__ int opaque_tid(int wv) { int lane_; asm volatile("v_mbcnt_lo_u32_b32 %0, -1, 0\n\tv_mbcnt_hi_u32_b32 %0, -1, %0" : "=v"(lane_)); return (wv << 6) | lane_; }
__device__ __forceinline__ unsigned char* opq_ptr(unsigned char* p) { asm volatile("" : "+s"(p)); return p; }
__device__ __forceinline__ f32x16 mfma32(bf16x8 a, bf16x8 b, f32x16 c) { return __builtin_amdgcn_mfma_f32_32x32x16_bf16(a, b, c, 0, 0, 0); }
__device__ __forceinline__ f32x16 zero16() { f32x16 z;
#pragma unroll
    for (int i = 0; i < 16; ++i) z[i] = 0.f;
    return z; }

namespace pg8 {
constexpr int BM = 256, BK = 64, HALF = 128, HTB = HALF * BK * 2, STAGE_BYTES = 8 * HTB, NXCD = 8, WGM = 8;
__device__ __forceinline__ int lds_byte(int r, int c) { const int st = (r >> 4) * 2 + (c >> 5), rr = r & 15, cc = c & 31, ob = rr * 64 + cc * 2; return st * 1024 + (ob ^ (((ob >> 9) & 1) << 5)); }
__device__ __forceinline__ void stage_rc(int b, int& R, int& C) { const int st = b / 1024, sb = b % 1024, swz = sb ^ (((sb >> 9) & 1) << 5); R = (st >> 1) * 16 + swz / 64; C = (st & 1) * 32 + (swz % 64) / 2; }
struct Unit { int pm, pn; };
struct Gemm { const bf16_t* A; const bf16_t* Bt; int M, N, K, lda; };
struct StaticOrder {
    int nM, nN, nwg, G, c, rev;
    __device__ void init(int M, int N, int G_, int c_, int rev_ = 0) { nM = M / BM; nN = N / BM; nwg = nM * nN; G = G_; c = c_; rev = rev_; }
    __device__ bool next(int i, Unit& u) const {
        const long L = (long)i * G + c; if (c < 0 || L >= nwg) return false;
        int wgid = (int)L; { const int q = nwg / NXCD, r = nwg % NXCD, xcd = wgid % NXCD, off = wgid / NXCD; wgid = (xcd < r ? xcd * (q + 1) : r * (q + 1) + (xcd - r) * q) + off; }
        const int nig = WGM * nN, gid = wgid / nig, fm = gid * WGM, gsz = (nM - fm) < WGM ? (nM - fm) : WGM;
        u.pm = fm + ((wgid % nig) % gsz); u.pn = (wgid % nig) / gsz; if (rev) u.pm = nM - 1 - u.pm;
        return true;
    }
};
template <class Epi, class Sched>
__device__ __forceinline__ void gemm_phase(LAS unsigned char* lds, const Gemm g, const Sched& S, const Epi& E, int wv__) {
    const int tid = opaque_tid(wv__), wid = __builtin_amdgcn_readfirstlane(tid >> 6), lane = tid & 63, wr = wid >> 2, wc = wid & 3, fr = lane & 15, fq = lane >> 4;
    const int K = g.K, nt = K / BK, lda = g.lda;
    unsigned voffA[2], voffB[2];
#pragma unroll
    for (int i = 0; i < 2; ++i) { int R, C; stage_rc(tid * 16 + i * 8192, R, C); voffA[i] = (unsigned)(R * lda + C) * 2u; voffB[i] = (unsigned)(R * K + C) * 2u; }
    const size_t kstep = (size_t)(BK * 2);
    const size_t hstepA = (size_t)HALF * lda * 2, hstepB = (size_t)HALF * K * 2;
    const size_t tstepA = 2 * hstepA, tstepB = 2 * hstepB;
    const unsigned ldsw = (unsigned)wid * 1024u;
    const int aoff = lds_byte(wr * 64 + fr, fq * 8), boff = lds_byte(wc * 32 + fr, fq * 8);
#define PG8_SA(b, h) (((b) * 2 + (h)) * HTB)
#define PG8_SB(b, h) ((4 + (b) * 2 + (h)) * HTB)
#define PG8_STAGE(bufoff, gbase, voff) do { _Pragma("unroll") for (int _i = 0; _i < 2; ++_i) \
        __builtin_amdgcn_global_load_lds((const unsigned*)((const char*)(gbase) + (voff)[_i]), (LAS unsigned*)(lds + (bufoff) + ldsw + _i * 8192), 16, 0, 0); } while (0)
#define PG8_LDA(dst, b, h) do { _Pragma("unroll") for (int m = 0; m < 4; ++m) _Pragma("unroll") for (int k = 0; k < 2; ++k) dst[m][k] = *(const LAS bf16x8*)(lds + PG8_SA(b, h) + aoff + m * 2048 + k * 1024); } while (0)
#define PG8_LDB(dst, b, h) do { _Pragma("unroll") for (int n = 0; n < 2; ++n) _Pragma("unroll") for (int k = 0; k < 2; ++k) dst[n][k] = *(const LAS bf16x8*)(lds + PG8_SB(b, h) + boff + n * 2048 + k * 1024); } while (0)
#define PG8_MMA(ai, bj, At, Bt) do { __builtin_amdgcn_s_setprio(1); _Pragma("unroll") for (int m = 0; m < 4; ++m) _Pragma("unroll") for (int n = 0; n < 2; ++n) _Pragma("unroll") for (int k = 0; k < 2; ++k) \
        acc[ai][bj][m][n] = __builtin_amdgcn_mfma_f32_16x16x32_bf16(Bt[n][k], At[m][k], acc[ai][bj][m][n], 0, 0, 0); __builtin_amdgcn_s_setprio(0); } while (0)
#define PG8_WAIT_V(n) asm volatile("s_waitcnt vmcnt(" #n ")" ::: "memory")
#define PG8_WAIT_L(n) asm volatile("s_waitcnt lgkmcnt(" #n ")" ::: "memory")
#define PG8_BAR __builtin_amdgcn_s_barrier()
#define PG8_SCHED __builtin_amdgcn_sched_barrier(0)
    Unit cur, nxt; int ui = 0;
    (void)S.next(0, cur);
    f32x4 acc[2][2][4][2];
#pragma unroll
    for (int a = 0; a < 2; ++a)
#pragma unroll
        for (int b = 0; b < 2; ++b)
#pragma unroll
            for (int m = 0; m < 4; ++m)
#pragma unroll
                for (int n = 0; n < 2; ++n) acc[a][b][m][n] = (f32x4){0.f, 0.f, 0.f, 0.f};
    bf16x8 At[4][2], B0[2][2], B1[2][2];
    const char* cA = (const char*)g.A + (size_t)cur.pm * tstepA; const char* cB = (const char*)g.Bt + (size_t)cur.pn * tstepB;
    PG8_STAGE(PG8_SB(0, 0), cB, voffB); PG8_STAGE(PG8_SA(0, 0), cA, voffA); PG8_STAGE(PG8_SB(0, 1), cB + hstepB, voffB); PG8_STAGE(PG8_SA(0, 1), cA + hstepA, voffA);
    if (wr == 1) PG8_BAR;
    PG8_WAIT_V(4); PG8_BAR;
    PG8_STAGE(PG8_SB(1, 0), cB + kstep, voffB); PG8_STAGE(PG8_SA(1, 0), cA + kstep, voffA); PG8_STAGE(PG8_SB(1, 1), cB + hstepB + kstep, voffB);
    PG8_WAIT_V(6); PG8_BAR;
    for (;;) {
        const bool has_next = S.next(ui + 1, nxt);
        const char* nA = has_next ? (const char*)g.A + (size_t)nxt.pm * tstepA : cA; const char* nB = has_next ? (const char*)g.Bt + (size_t)nxt.pn * tstepB : cB;
        for (int t = 0; t < nt; t += 2) {
            const bool last = (t == nt - 2);
            const char* a1 = cA + (size_t)(t + 1) * kstep;
            const char* a2 = last ? nA : cA + (size_t)(t + 2) * kstep; const char* b2 = last ? nB : cB + (size_t)(t + 2) * kstep;
            const char* a3 = a2 + kstep; const char* b3 = b2 + kstep;
            PG8_LDB(B0, 0, 0); PG8_SCHED; PG8_LDA(At, 0, 0); PG8_STAGE(PG8_SA(1, 1), a1 + hstepA, voffA);
            PG8_WAIT_L(8); PG8_BAR; PG8_WAIT_L(0); PG8_MMA(0, 0, At, B0); PG8_BAR; PG8_SCHED;
            PG8_LDB(B1, 0, 1); PG8_STAGE(PG8_SB(0, 0), b2, voffB);
            PG8_BAR; PG8_WAIT_L(0); PG8_MMA(0, 1, At, B1); PG8_BAR;
            PG8_LDA(At, 0, 1); PG8_STAGE(PG8_SA(0, 0), a2, voffA);
            PG8_BAR; PG8_WAIT_L(0); PG8_MMA(1, 0, At, B0); PG8_BAR; PG8_SCHED;
            PG8_STAGE(PG8_SB(0, 1), b2 + hstepB, voffB);
            PG8_WAIT_V(6); PG8_BAR; PG8_MMA(1, 1, At, B1); PG8_BAR;
            PG8_LDB(B0, 1, 0); PG8_SCHED; PG8_LDA(At, 1, 0); PG8_STAGE(PG8_SA(0, 1), a2 + hstepA, voffA);
            PG8_WAIT_L(8); PG8_BAR; PG8_WAIT_L(0); PG8_MMA(0, 0, At, B0); PG8_BAR; PG8_SCHED;
            PG8_LDB(B1, 1, 1); PG8_STAGE(PG8_SB(1, 0), b3, voffB);
            PG8_BAR; PG8_WAIT_L(0); PG8_MMA(0, 1, At, B1); PG8_BAR;
            PG8_LDA(At, 1, 1); PG8_STAGE(PG8_SA(1, 0), a3, voffA);
            PG8_BAR; PG8_WAIT_L(0); PG8_MMA(1, 0, At, B0); PG8_BAR; PG8_SCHED;
            PG8_STAGE(PG8_SB(1, 1), b3 + hstepB, voffB);
            PG8_WAIT_V(6); PG8_BAR; PG8_MMA(1, 1, At, B1); PG8_BAR;
        }
        E(acc, cur, wr, wc, fr, fq);
        if (!has_next) break;
#pragma unroll
        for (int a = 0; a < 2; ++a)
#pragma unroll
            for (int b = 0; b < 2; ++b)
#pragma unroll
                for (int m = 0; m < 4; ++m)
#pragma unroll
                    for (int n = 0; n < 2; ++n) acc[a][b][m][n] = (f32x4){0.f, 0.f, 0.f, 0.f};
        cur = nxt; cA = nA; cB = nB; ++ui;
    }
    PG8_WAIT_V(0);
    if (wr == 0) PG8_BAR;
    PG8_BAR;
#undef PG8_SA
#undef PG8_SB
#undef PG8_STAGE
#undef PG8_LDA
#undef PG8_LDB
#undef PG8_MMA
#undef PG8_WAIT_V
#undef PG8_WAIT_L
#undef PG8_BAR
#undef PG8_SCHED
}
}
using pg8::Unit;
typedef f32x4 AccT[2][2][4][2];

struct EpiPlain {
    bf16_t* O; int ldc;
    __device__ __forceinline__ void operator()(const AccT& acc, const Unit& u, int wr, int wc, int fr, int fq) const {
        const int row0 = u.pm * 256 + wr * 64 + fr, col0 = u.pn * 256 + wc * 32 + 4 * fq;
#pragma unroll
        for (int ai = 0; ai < 2; ++ai)
#pragma unroll
            for (int m = 0; m < 4; ++m) { bf16_t* rowp = O + (size_t)(row0 + ai * 128 + m * 16) * ldc + col0;
#pragma unroll
                for (int bj = 0; bj < 2; ++bj)
#pragma unroll
                    for (int n = 0; n < 2; ++n) { const f32x4 v = acc[ai][bj][m][n]; *(u32x2*)(rowp + bj * 128 + n * 16) = (u32x2){cvt_pk_bf16(v[0], v[1]), cvt_pk_bf16(v[2], v[3])}; } }
    }
};
struct EpiSwiGLU {
    bf16_t* O;
    __device__ __forceinline__ void operator()(const AccT& acc, const Unit& u, int wr, int wc, int fr, int fq) const {
        const int row0 = u.pm * 256 + wr * 64 + fr, col0 = u.pn * 128 + wc * 32 + 4 * fq;
#pragma unroll
        for (int ai = 0; ai < 2; ++ai)
#pragma unroll
            for (int m = 0; m < 4; ++m) { bf16_t* rowp = O + (size_t)(row0 + ai * 128 + m * 16) * FF + col0;
#pragma unroll
                for (int n = 0; n < 2; ++n) { const f32x4 g = acc[ai][0][m][n], up = acc[ai][1][m][n]; float r[4];
#pragma unroll
                    for (int i = 0; i < 4; ++i) r[i] = g[i] * up[i] * fast_sigmoid(g[i]);
                    *(u32x2*)(rowp + n * 16) = (u32x2){cvt_pk_bf16(r[0], r[1]), cvt_pk_bf16(r[2], r[3])}; } }
    }
};
struct EpiGelu {
    bf16_t* O; const float* bias;
    __device__ __forceinline__ void operator()(const AccT& acc, const Unit& u, int wr, int wc, int fr, int fq) const {
        const int row0 = u.pm * 256 + wr * 64 + fr, col0 = u.pn * 256 + wc * 32 + 4 * fq;
#pragma unroll
        for (int ai = 0; ai < 2; ++ai)
#pragma unroll
            for (int m = 0; m < 4; ++m) { bf16_t* rowp = O + (size_t)(row0 + ai * 128 + m * 16) * 256 + col0;
#pragma unroll
                for (int bj = 0; bj < 2; ++bj)
#pragma unroll
                    for (int n = 0; n < 2; ++n) { const f32x4 v = acc[ai][bj][m][n]; const f32x4 b = *(const f32x4*)(bias + col0 + bj * 128 + n * 16); float r[4];
#pragma unroll
                        for (int i = 0; i < 4; ++i) { const float x = v[i] + b[i]; const float u2 = 1.5957691216057308f * (x + 0.044715f * x * x * x); r[i] = x * sigmoidf_(u2); }
                        *(u32x2*)(rowp + bj * 128 + n * 16) = (u32x2){cvt_pk_bf16(r[0], r[1]), cvt_pk_bf16(r[2], r[3])}; } }
    }
};
struct EpiWin {
    bf16_t* P; bf16_t* kcin; bf16_t* vcin; const f32x2* rope;
    __device__ __forceinline__ static bool roped(int hb) { return hb == C_KSLC || hb == C_KWIN || (hb >= C_RETK && hb < C_RETV) || (hb >= C_SWAK && hb < C_SWAV); }
    __device__ __forceinline__ void operator()(const AccT& acc, const Unit& u, int wr, int wc, int fr, int fq) const {
        const int row0 = u.pm * 256 + wr * 64 + fr;
#pragma unroll
        for (int bj = 0; bj < 2; ++bj) {
            const int base = u.pn * 256 + bj * 128 + wc * 32;
            const int hb = base & ~63;
            if (roped(hb)) {
                const int d1 = 16 * (wc & 1) + 4 * fq;
#pragma unroll
                for (int ai = 0; ai < 2; ++ai)
#pragma unroll
                    for (int m = 0; m < 4; ++m) { const int row = row0 + ai * 128 + m * 16; const f32x2* cs = rope + (size_t)(row & (S_ - 1)) * 32 + d1;
                        const f32x4 c01 = *(const f32x4*)cs, c23 = *(const f32x4*)(cs + 2);
                        const f32x4 a = acc[ai][bj][m][0], b = acc[ai][bj][m][1];
                        const float co[4] = {c01[0], c01[2], c23[0], c23[2]}, si[4] = {c01[1], c01[3], c23[1], c23[3]}; float o1[4], o2[4];
#pragma unroll
                        for (int i = 0; i < 4; ++i) { o1[i] = a[i] * co[i] - b[i] * si[i]; o2[i] = b[i] * co[i] + a[i] * si[i]; }
                        bf16_t* rp = P + (size_t)row * LDP + hb + d1;
                        *(u32x2*)rp = (u32x2){cvt_pk_bf16(o1[0], o1[1]), cvt_pk_bf16(o1[2], o1[3])};
                        *(u32x2*)(rp + 32) = (u32x2){cvt_pk_bf16(o2[0], o2[1]), cvt_pk_bf16(o2[2], o2[3])}; }
            } else {
#pragma unroll
                for (int ai = 0; ai < 2; ++ai)
#pragma unroll
                    for (int m = 0; m < 4; ++m) { const int row = row0 + ai * 128 + m * 16;
#pragma unroll
                        for (int n = 0; n < 2; ++n) { const int col = base + n * 16 + 4 * fq; const f32x4 v = acc[ai][bj][m][n];
                            const u32x2 w = (u32x2){cvt_pk_bf16(v[0], v[1]), cvt_pk_bf16(v[2], v[3])};
                            *(u32x2*)(P + (size_t)row * LDP + col) = w;
                            if (hb == C_KCMP) *(u32x2*)(kcin + (size_t)row * 64 + (col - C_KCMP)) = w;
                            if (hb == C_VCMP) *(u32x2*)(vcin + (size_t)row * 64 + (col - C_VCMP)) = w; } }
            }
        }
    }
};
struct EpiMerge {
    const bf16_t* Z[4]; bf16_t* O;
    __device__ __forceinline__ void operator()(const AccT& acc, const Unit& u, int wr, int wc, int fr, int fq) const {
        const int row0 = u.pm * 256 + wr * 64 + fr, col = u.pn * 64 + wc * 16 + 4 * fq;
#pragma unroll
        for (int ai = 0; ai < 2; ++ai) {
            u32x2 zz[4][4];
#pragma unroll
            for (int m = 0; m < 4; ++m) { const size_t off = (size_t)(row0 + ai * 128 + m * 16) * DM + col;
#pragma unroll
                for (int br = 0; br < 4; ++br) zz[m][br] = *(const u32x2*)(Z[br] + off); }
#pragma unroll
            for (int m = 0; m < 4; ++m) { const size_t off = (size_t)(row0 + ai * 128 + m * 16) * DM + col; float r[4] = {0.f, 0.f, 0.f, 0.f};
#pragma unroll
                for (int br = 0; br < 4; ++br) { const f32x4 g = acc[ai][br >> 1][m][br & 1]; const u32x2 z = zz[m][br];
                    r[0] += fast_sigmoid(g[0]) * bf_lo(z[0]); r[1] += fast_sigmoid(g[1]) * bf_hi(z[0]); r[2] += fast_sigmoid(g[2]) * bf_lo(z[1]); r[3] += fast_sigmoid(g[3]) * bf_hi(z[1]); }
                *(u32x2*)(O + off) = (u32x2){cvt_pk_bf16(r[0], r[1]), cvt_pk_bf16(r[2], r[3])}; }
        }
    }
};

template <class Epi>
__device__ __forceinline__ void run_gemm(LAS unsigned char* lds, const bf16_t* A, int lda, const bf16_t* Bt, int M, int N, int K, const Epi& E, int G, int c, int wv__, int rev = 0) {
    pg8::Gemm g; g.A = A; g.Bt = Bt; g.M = M; g.N = N; g.K = K; g.lda = lda;
    pg8::StaticOrder S; S.init(M, N, G, c, rev);
    pg8::gemm_phase<Epi, pg8::StaticOrder>(lds, g, S, E, wv__);
}

struct MapId { const float* src; int ld; __device__ const float* ptr(int n) const { return src + n; } };
struct MapGU { const float* g; const float* u; int ld; __device__ const float* ptr(int n) const { const int j = n >> 8, w = n & 255; return (w < 128) ? g + 128 * j + w : u + 128 * j + (w - 128); } };
__device__ __forceinline__ int swap45(int x) { return (x & ~48) | ((x & 16) << 1) | ((x & 32) >> 1); }
struct MapWin { const float* src; int ld;
    __device__ const float* ptr(int n) const {
        if (n >= 3776 || (n >= 652 && n < 704)) return nullptr;
        const int hb = n & ~63; int c = n;
        if (EpiWin::roped(hb)) c = hb + swap45(n - hb);
        return src + (c < 652 ? c : c - 52); } };
struct MapGate { const float* src; int ld;
    __device__ const float* ptr(int n) const { const int pn = n >> 8, rho = n & 255, bj = rho >> 7, wc = (rho >> 5) & 3, nn = (rho >> 4) & 1, q = rho & 15;
        return src + 3724 + (2 * bj + nn) * 1024 + 64 * pn + 16 * wc + q; } };

template <class Map>
__device__ __forceinline__ void conv_tiles(const Map mp, int K, int N, bf16_t* dst, LAS float* tile, int& item_base, int bid, int nb, int wv__) {
    const int nn = N / 64, total = (K / 64) * nn, tid = opaque_tid(wv__);
    const int first = (bid - (item_base % nb) + nb) % nb;
    const int ty = tid >> 6, tx = tid & 63, wn = tid >> 3, kc = tid & 7;
    for (int it0 = first; it0 < total; it0 += 4 * nb) {
#pragma unroll
        for (int u = 0; u < 4; ++u) { const int it = it0 + u * nb; if (it < total) { const int k0 = (it / nn) * 64, n0 = (it % nn) * 64; const float* sp = mp.ptr(n0 + tx); LAS float* tl = tile + u * 4160;
#pragma unroll
            for (int kk = ty; kk < 64; kk += 8) tl[kk * 65 + tx] = sp ? sp[(size_t)(k0 + kk) * mp.ld] : 0.f; } }
        __syncthreads();
#pragma unroll
        for (int u = 0; u < 4; ++u) { const int it = it0 + u * nb; if (it < total) { const int k0 = (it / nn) * 64, n0 = (it % nn) * 64; const LAS float* sl = tile + u * 4160 + (8 * kc) * 65 + wn;
            u32x4 o; o.x = cvt_pk_bf16(sl[0], sl[65]); o.y = cvt_pk_bf16(sl[2 * 65], sl[3 * 65]); o.z = cvt_pk_bf16(sl[4 * 65], sl[5 * 65]); o.w = cvt_pk_bf16(sl[6 * 65], sl[7 * 65]);
            *(u32x4*)(dst + (size_t)(n0 + wn) * K + k0 + 8 * kc) = o; } }
        __syncthreads();
    }
    item_base += total;
}

__device__ __forceinline__ void phase_convert(const Params& P, int l, LAS unsigned char* lds, int bid, int nb, int wv__) {
    const int ctid = opaque_tid(wv__); bf16_t* W = (bf16_t*)(P.ws + WS_W); LAS float* tile = (LAS float*)lds;
    {
        constexpr int NM = 13;
        const int mK[NM] = {DM, FF, DM, DM, 256, 512, 256, 256, DM, DM, FF, 2048, 2048};
        const int mN[NM] = {5632, DM, LDP, 4096, DM, DM, DM, DM, DM, 5632, DM, 256, 256};
        const size_t mD[NM] = {W_GU1, W_D1, W_IN, W_GATE, W_PNSA, W_PRET, W_PRWKV, W_PSWA, W_OUT, W_GU2, W_D2, W_CK1, W_CV1};
        int total = 0;
#pragma unroll
        for (int m = 0; m < NM; ++m) total += (mK[m] / 64) * (mN[m] / 64);
        const int ty = ctid >> 6, tx = ctid & 63, wn = ctid >> 3, kc = ctid & 7;
        const float* win = P.in[I_WIN] + (size_t)l * DM * NCOL;
        int tk0[4], tn0[4], tm[4]; float vals[4][8];
        auto decode_load = [&](int g0) {
#pragma unroll
            for (int u = 0; u < 4; ++u) { int g = g0 + u * nb; tm[u] = -1; tk0[u] = 0; tn0[u] = 0;
                if (g < total) {
#pragma unroll
                    for (int m = 0; m < NM; ++m) { const int nn = mN[m] / 64, cnt = (mK[m] / 64) * nn; if (tm[u] < 0) { if (g < cnt) { tm[u] = m; tk0[u] = (g / nn) * 64; tn0[u] = (g % nn) * 64; } else g -= cnt; } } } }
#pragma unroll
            for (int u = 0; u < 4; ++u) {
#pragma unroll
                for (int e = 0; e < 8; ++e) vals[u][e] = 0.f;
                if (tm[u] >= 0) { const int m = tm[u], n = tn0[u] + tx; const float* sp; int ld;
                    switch (m) {
                        case 0: sp = MapGU{P.in[I_F1G] + (size_t)l * DM * FF, P.in[I_F1U] + (size_t)l * DM * FF, FF}.ptr(n); ld = FF; break;
                        case 1: sp = P.in[I_F1D] + (size_t)l * FF * DM + n; ld = DM; break;
                        case 2: sp = MapWin{win, NCOL}.ptr(n); ld = NCOL; break;
                        case 3: sp = MapGate{win, NCOL}.ptr(n); ld = NCOL; break;
                        case 4: sp = P.in[I_PNSA] + (size_t)l * 256 * DM + n; ld = DM; break;
                        case 5: sp = P.in[I_PRET] + (size_t)l * 512 * DM + n; ld = DM; break;
                        case 6: sp = P.in[I_PRWKV] + (size_t)l * 256 * DM + n; ld = DM; break;
                        case 7: sp = P.in[I_PSWA] + (size_t)l * 256 * DM + n; ld = DM; break;
                        case 8: sp = P.in[I_WOUT] + (size_t)l * DM * DM + n; ld = DM; break;
                        case 9: sp = MapGU{P.in[I_F2G] + (size_t)l * DM * FF, P.in[I_F2U] + (size_t)l * DM * FF, FF}.ptr(n); ld = FF; break;
                        case 10: sp = P.in[I_F2D] + (size_t)l * FF * DM + n; ld = DM; break;
                        case 11: sp = P.in[I_CKW1] + (size_t)l * 2048 * 256 + n; ld = 256; break;
                        default: sp = P.in[I_CVW1] + (size_t)l * 2048 * 256 + n; ld = 256; break;
                    }
                    if (sp) {
#pragma unroll
                        for (int e = 0; e < 8; ++e) vals[u][e] = sp[(size_t)(tk0[u] + ty + 8 * e) * ld]; } } } };
        decode_load(bid);
        for (int g0 = bid; g0 < total; g0 += 4 * nb) {
            int ck0[4], cn0[4], cm[4];
#pragma unroll
            for (int u = 0; u < 4; ++u) { ck0[u] = tk0[u]; cn0[u] = tn0[u]; cm[u] = tm[u];
                if (tm[u] >= 0) { LAS float* tl = tile + u * 4160;
#pragma unroll
                    for (int e = 0; e < 8; ++e) tl[(ty + 8 * e) * 65 + tx] = vals[u][e]; } }
            __syncthreads();
            if (g0 + 4 * nb < total) decode_load(g0 + 4 * nb);
#pragma unroll
            for (int u = 0; u < 4; ++u) if (cm[u] >= 0) { const LAS float* sl = tile + u * 4160 + (8 * kc) * 65 + wn;
                u32x4 o; o.x = cvt_pk_bf16(sl[0], sl[65]); o.y = cvt_pk_bf16(sl[2 * 65], sl[3 * 65]); o.z = cvt_pk_bf16(sl[4 * 65], sl[5 * 65]); o.w = cvt_pk_bf16(sl[6 * 65], sl[7 * 65]);
                *(u32x4*)(W + mD[cm[u]] + (size_t)(cn0[u] + wn) * mK[cm[u]] + ck0[u] + 8 * kc) = o; }
            __syncthreads();
        }
    }
    if (bid < 64) {
        const int kv = bid >> 5, cidx = bid & 31, j = ctid & 255, half = ctid >> 8;
        const float* pos = P.in[kv ? I_POSV : I_POSK] + (size_t)l * 2048 + 64 * cidx + 32 * half; const float* w1 = P.in[kv ? I_CVW1 : I_CKW1] + (size_t)l * 2048 * 256 + (size_t)(64 * cidx + 32 * half) * 256 + j;
        float sacc = 0.f;
#pragma unroll 8
        for (int i = 0; i < 32; ++i) sacc += pos[i] * w1[(size_t)i * 256];
        __syncthreads();
        if (half) tile[j] = sacc;
        __syncthreads();
        if (!half) ((float*)(P.ws + WS_MISC + X_CBP))[(kv * 32 + cidx) * 256 + j] = sacc + tile[j];
        __syncthreads();
    }
    if (l == 0) {
        f32x2* rope = (f32x2*)(P.ws + WS_MISC + X_ROPE);
        for (int e = bid * 512 + ctid; e < S_ * 32; e += nb * 512) {
            const int pos = e >> 5, i = e & 31; const float invf = powf(10000.0f, -(float)i * 2.0f / 64.0f); const float ang = (float)pos * invf;
            double a = (double)ang; const double k = rint(a * 0.15915494309189535); a -= k * 6.283185307179586;
            const float af = (float)a; rope[e] = (f32x2){cosf(af), sinf(af)}; }
        bf16_t* kc = (bf16_t*)(P.ws + WS_Z3 + M_KCIN); bf16_t* vc = (bf16_t*)(P.ws + WS_Z3 + M_VCIN);
        for (int e = bid * 512 + ctid; e < 64 * 64; e += nb * 512) { kc[(size_t)T_ * 64 + e] = 0; vc[(size_t)T_ * 64 + e] = 0; }
    }
}

__device__ __forceinline__ void phase_rowpass(const float* xin, const bf16_t* F, const float* gpost, float coef, float* xout, const float* gpre, bf16_t* h, int bid, int nb, int wv__) {
    const int tid_ = opaque_tid(wv__), lane = tid_ & 63, gw = bid * 8 + (tid_ >> 6), NGW = nb * 8;
    f32x4 gpo[4], gpr[4];
#pragma unroll
    for (int j = 0; j < 4; ++j) { gpo[j] = F ? ((const f32x4*)gpost)[64 * j + lane] : (f32x4){0.f, 0.f, 0.f, 0.f}; gpr[j] = gpre ? ((const f32x4*)gpre)[64 * j + lane] : (f32x4){0.f, 0.f, 0.f, 0.f}; }
    f32x4 xn[4]; u32x2 fn[4];
    if (gw < T_) {
#pragma unroll
        for (int j = 0; j < 4; ++j) { xn[j] = ((const f32x4*)(xin + (size_t)gw * DM) + lane)[64 * j]; fn[j] = F ? ((const u32x2*)(F + (size_t)gw * DM) + lane)[64 * j] : (u32x2){0u, 0u}; } }
    for (int row = gw; row < T_; row += NGW) {
        f32x4 x[4]; u32x2 fw[4];
#pragma unroll
        for (int j = 0; j < 4; ++j) { x[j] = xn[j]; fw[j] = fn[j]; }
        const int nrow = row + NGW;
        if (nrow < T_) {
#pragma unroll
            for (int j = 0; j < 4; ++j) { xn[j] = ((const f32x4*)(xin + (size_t)nrow * DM) + lane)[64 * j]; fn[j] = F ? ((const u32x2*)(F + (size_t)nrow * DM) + lane)[64 * j] : (u32x2){0u, 0u}; } }
        if (F) {
            f32x4 f[4]; float s = 0.f;
#pragma unroll
            for (int j = 0; j < 4; ++j) { const u32x2 w = fw[j]; f[j] = (f32x4){bf_lo(w[0]), bf_hi(w[0]), bf_lo(w[1]), bf_hi(w[1])}; s += (f[j][0] * f[j][0] + f[j][1] * f[j][1]) + (f[j][2] * f[j][2] + f[j][3] * f[j][3]); }
            const float rs = coef * rsqrtf(wave_sum(s) * (1.0f / DM) + 1e-6f);
#pragma unroll
            for (int j = 0; j < 4; ++j) x[j] = x[j] + f[j] * gpo[j] * rs;
        }
        f32x4* xo = (f32x4*)(xout + (size_t)row * DM) + lane;
#pragma unroll
        for (int j = 0; j < 4; ++j) if (xout) xo[64 * j] = x[j];
        if (gpre) {
            float s = 0.f;
#pragma unroll
            for (int j = 0; j < 4; ++j) s += (x[j][0] * x[j][0] + x[j][1] * x[j][1]) + (x[j][2] * x[j][2] + x[j][3] * x[j][3]);
            const float rs = rsqrtf(wave_sum(s) * (1.0f / DM) + 1e-6f);
            u32x2* ho = (u32x2*)(h + (size_t)row * DM) + lane;
#pragma unroll
            for (int j = 0; j < 4; ++j) { const f32x4 v = x[j] * gpr[j] * rs; ho[64 * j] = (u32x2){cvt_pk_bf16(v[0], v[1]), cvt_pk_bf16(v[2], v[3])}; }
        }
    }
}

constexpr int A_KS = 0, A_VTS = 9216, A_MISC = 32768, A_BUF1 = 57344;
struct QF { bf16x8 f[4]; };
__device__ __forceinline__ bf16x8 pack8(const float* v) { u32x4 w = (u32x4){cvt_pk_bf16(v[0], v[1]), cvt_pk_bf16(v[2], v[3]), cvt_pk_bf16(v[4], v[5]), cvt_pk_bf16(v[6], v[7])}; return __builtin_bit_cast(bf16x8, w); }
__device__ __forceinline__ void load_q(QF& q, const bf16_t* qrow, int h, const f32x2* ropeRow, float scale) {
    float v[4][8];
#pragma unroll
    for (int ks = 0; ks < 4; ++ks) { const u32x4 w = *(const u32x4*)(qrow + 16 * ks + 8 * h);
        v[ks][0] = bf_lo(w.x); v[ks][1] = bf_hi(w.x); v[ks][2] = bf_lo(w.y); v[ks][3] = bf_hi(w.y); v[ks][4] = bf_lo(w.z); v[ks][5] = bf_hi(w.z); v[ks][6] = bf_lo(w.w); v[ks][7] = bf_hi(w.w); }
    if (ropeRow) {
#pragma unroll
        for (int ks = 0; ks < 2; ++ks)
#pragma unroll
            for (int j = 0; j < 8; ++j) { const f32x2 cs = ropeRow[16 * ks + 8 * h + j]; const float a = v[ks][j], b = v[ks + 2][j]; v[ks][j] = a * cs.x - b * cs.y; v[ks + 2][j] = b * cs.x + a * cs.y; }
    }
#pragma unroll
    for (int ks = 0; ks < 4; ++ks) {
#pragma unroll
        for (int j = 0; j < 8; ++j) v[ks][j] *= scale;
        q.f[ks] = pack8(v[ks]); }
}
__device__ __forceinline__ void qk_tile(const LAS unsigned char* Ks, const QF& q, int r, int h, f32x16 (&s)[2]) {
#pragma unroll
    for (int kt = 0; kt < 2; ++kt) { s[kt] = zero16();
#pragma unroll
        for (int ks = 0; ks < 4; ++ks) { const bf16x8 a = *(const LAS bf16x8*)(Ks + ((32 * kt + r) * 72 + 16 * ks + 8 * h) * 2); s[kt] = mfma32(a, q.f[ks], s[kt]); } }
}
__device__ __forceinline__ void pv_tile(const LAS unsigned char* Vts, int vrow0, const f32x16 (&p)[2], int r, int h, f32x16 (&o)[2]) {
#pragma unroll
    for (int kt = 0; kt < 2; ++kt)
#pragma unroll
        for (int s2 = 0; s2 < 2; ++s2) { float t[8];
#pragma unroll
            for (int j = 0; j < 8; ++j) t[j] = p[kt][8 * s2 + j];
            const bf16x8 pf = pack8(t);
#pragma unroll
            for (int dt = 0; dt < 2; ++dt) { const LAS unsigned char* ap = Vts + ((vrow0 + 32 * dt + r) * 68 + 32 * kt + 16 * s2 + 4 * h) * 2;
                const u32x2 lo = *(const LAS u32x2*)ap, hi = *(const LAS u32x2*)(ap + 16);
                const bf16x8 a = __builtin_bit_cast(bf16x8, (u32x4){lo.x, lo.y, hi.x, hi.y}); o[dt] = mfma32(a, pf, o[dt]); } }
}
template <bool FULL>
__device__ __forceinline__ void softmax_update(f32x16 (&s)[2], int lo, int hi, int h, float& m, float& l, f32x16 (&o)[2]) {
    float mx = m;
#pragma unroll
    for (int kt = 0; kt < 2; ++kt)
#pragma unroll
        for (int reg = 0; reg < 16; ++reg) {
            if (!FULL) { const int kl = 32 * kt + (reg & 3) + 8 * (reg >> 2) + 4 * h; const bool v = (kl >= lo) && (kl <= hi); s[kt][reg] = v ? s[kt][reg] : -INFINITY; }
            mx = fmaxf(mx, s[kt][reg]); }
    mx = fmaxf(mx, __shfl_xor(mx, 32));
    if (__any(mx > m)) {
        const float alpha = fast_exp2(m - mx); m = mx; l *= alpha;
#pragma unroll
        for (int dt = 0; dt < 2; ++dt) o[dt] = o[dt] * alpha;
    }
    float ls = 0.f;
#pragma unroll
    for (int kt = 0; kt < 2; ++kt)
#pragma unroll
        for (int reg = 0; reg < 16; ++reg) { const float p = fast_exp2(s[kt][reg] - mx); s[kt][reg] = p; ls += p; }
    l += ls;
}
__device__ __forceinline__ void store_kv_tile(LAS unsigned char* shm, u32x4 kreg, u32x4 vreg, int key, int c) {
    *(LAS u32x4*)(shm + A_KS + key * 144 + c * 16) = kreg;
    LAS bf16_t* vt = (LAS bf16_t*)(shm + A_VTS) + (8 * c) * 68 + key;
    vt[0] = (bf16_t)(vreg.x & 0xffff); vt[68] = (bf16_t)(vreg.x >> 16); vt[136] = (bf16_t)(vreg.y & 0xffff); vt[204] = (bf16_t)(vreg.y >> 16);
    vt[272] = (bf16_t)(vreg.z & 0xffff); vt[340] = (bf16_t)(vreg.z >> 16); vt[408] = (bf16_t)(vreg.w & 0xffff); vt[476] = (bf16_t)(vreg.w >> 16);
}
template <int MODE, class TR, class MK>
__device__ __forceinline__ void flash_loop(int ntiles, TR tileRow, MK maskAt, const bf16_t* Kg, const bf16_t* Vg, int ld, const QF& q, float& m, float& l, f32x16 (&o)[2],
                                           LAS unsigned char* shm, int tid, int lane, float inv = 0.f, LAS float* imp = nullptr, int qloc = 0) {
    if (ntiles <= 0) return;
    const int key = tid >> 3, c = tid & 7, r = lane & 31, h = lane >> 5;
    u32x4 kreg0, vreg0, kreg1 = (u32x4){0u, 0u, 0u, 0u}, vreg1 = (u32x4){0u, 0u, 0u, 0u};
    { const size_t off = (size_t)(tileRow(0) + key) * ld + 8 * c; kreg0 = *(const u32x4*)(Kg + off); vreg0 = *(const u32x4*)(Vg + off); }
    if (ntiles > 1) { const size_t off = (size_t)(tileRow(1) + key) * ld + 8 * c; kreg1 = *(const u32x4*)(Kg + off); vreg1 = *(const u32x4*)(Vg + off); }
    for (int i = 0; i < ntiles; i += 2) {
        __syncthreads();
        store_kv_tile(shm, kreg0, vreg0, key, c);
        if (i + 1 < ntiles) store_kv_tile(shm + A_BUF1, kreg1, vreg1, key, c);
        __syncthreads();
        if (i + 2 < ntiles) { const size_t off = (size_t)(tileRow(i + 2) + key) * ld + 8 * c; kreg0 = *(const u32x4*)(Kg + off); vreg0 = *(const u32x4*)(Vg + off); }
        if (i + 3 < ntiles) { const size_t off = (size_t)(tileRow(i + 3) + key) * ld + 8 * c; kreg1 = *(const u32x4*)(Kg + off); vreg1 = *(const u32x4*)(Vg + off); }
#pragma unroll 1
        for (int u = 0; u < 2; ++u) {
            const int ti = i + u; if (ti >= ntiles) break;
            LAS unsigned char* tb = shm + u * A_BUF1;
            int lo, hi; maskAt(ti, lo, hi);
            if (__all((hi < 0) || (lo > 63) || (hi < lo))) continue;
            const bool full = __all((lo <= 0) && (hi >= 63));
            f32x16 s[2]; qk_tile(tb + A_KS, q, r, h, s);
            if (MODE == 0) { if (full) softmax_update<true>(s, lo, hi, h, m, l, o); else softmax_update<false>(s, lo, hi, h, m, l, o); pv_tile(tb + A_VTS, 0, s, r, h, o); }
            else if (MODE == 1) { f32x16 dummy[2]; dummy[0] = zero16(); dummy[1] = zero16(); if (full) softmax_update<true>(s, lo, hi, h, m, l, dummy); else softmax_update<false>(s, lo, hi, h, m, l, dummy); }
            else {
#pragma unroll
                for (int kt = 0; kt < 2; ++kt)
#pragma unroll
                    for (int g = 0; g < 4; ++g) { float sum4 = 0.f, p3 = 0.f;
#pragma unroll
                        for (int e = 0; e < 4; ++e) { const int reg = 4 * g + e, kl = 32 * kt + 8 * g + 4 * h + e; const bool v = (kl >= lo) && (kl <= hi);
                            const float p = v ? fast_exp2(s[kt][reg] - m) * inv : 0.f; s[kt][reg] = p; sum4 += p; p3 = p; }
                        const int j = 16 * ti + 8 * kt + 2 * g + h;
                        __hip_atomic_fetch_add(imp + qloc * 65 + j, sum4, __ATOMIC_RELAXED, __HIP_MEMORY_SCOPE_WORKGROUP);
                        if (j + 1 < 64) __hip_atomic_fetch_add(imp + qloc * 65 + j + 1, p3, __ATOMIC_RELAXED, __HIP_MEMORY_SCOPE_WORKGROUP); }
                pv_tile(tb + A_VTS, 0, s, r, h, o);
            }
        }
    }
}

__device__ __forceinline__ void swa_item(const Params& P, int l, int it, LAS unsigned char* shm, int wv__) {
    const int tid = opaque_tid(wv__), lane = tid & 63, w = tid >> 6, r = lane & 31, h = lane >> 5;
    const int b = it >> 6, kvh = (it >> 5) & 1, qt = it & 31;
    const bf16_t* p = (const bf16_t*)(P.ws + WS_R1) + (size_t)b * S_ * LDP; const f32x2* rope = (const f32x2*)(P.ws + WS_MISC + X_ROPE);
    const int g = w >> 2, qsub = w & 3, head = 2 * kvh + g, qpos = 128 * qt + 32 * qsub + r;
    QF q; load_q(q, p + (size_t)qpos * LDP + C_SWAQ + 64 * head, h, rope + (size_t)qpos * 32, 0.125f * LOG2E);
    float m = P.in[I_SINK][l * 4 + head] * LOG2E, lsum = (h == 0) ? 1.f : 0.f; f32x16 o[2]; o[0] = zero16(); o[1] = zero16();
    const int j0 = (qt == 0) ? 0 : 2 * qt - 2, nt = 2 * qt + 2 - j0;
    flash_loop<0>(nt, [&](int i) { return 64 * (j0 + i); }, [&](int i, int& lo, int& hi) { const int tb = 64 * (j0 + i); lo = qpos - 127 - tb; hi = qpos - tb; },
                  p + C_SWAK + 64 * kvh, p + C_SWAV + 64 * kvh, LDP, q, m, lsum, o, shm, tid, lane);
    lsum += __shfl_xor(lsum, 32); const float inv = 1.0f / lsum;
    bf16_t* y = (bf16_t*)(P.ws + WS_Y + Y_SWA) + ((size_t)b * S_ + qpos) * 256 + 64 * head;
#pragma unroll
    for (int dt = 0; dt < 2; ++dt)
#pragma unroll
        for (int gg = 0; gg < 4; ++gg) { const f32x16& a = o[dt]; *(u32x2*)(y + 32 * dt + 8 * gg + 4 * h) = (u32x2){cvt_pk_bf16(a[4 * gg] * inv, a[4 * gg + 1] * inv), cvt_pk_bf16(a[4 * gg + 2] * inv, a[4 * gg + 3] * inv)}; }
}

__device__ __forceinline__ void nsa_cmp_item(const Params& P, int it, LAS unsigned char* shm, int wv__) {
    const int tid = opaque_tid(wv__), lane = tid & 63, w = tid >> 6, r = lane & 31, h = lane >> 5;
    const int b = it >> 6, qt = it & 63, q0 = 64 * qt;
    const bf16_t* p = (const bf16_t*)(P.ws + WS_R1) + (size_t)b * S_ * LDP;
    const bf16_t* kc = (const bf16_t*)(P.ws + WS_Z3 + M_KC) + (size_t)b * 256 * 64; const bf16_t* vc = (const bf16_t*)(P.ws + WS_Z3 + M_VC) + (size_t)b * 256 * 64;
    LAS float* imp = (LAS float*)(shm + A_MISC);
    for (int e = tid; e < 64 * 65; e += 512) imp[e] = 0.f;
    const int hd = w >> 1, qsub = w & 1, qloc = 32 * qsub + r, qpos = q0 + qloc;
    QF q; load_q(q, p + (size_t)qpos * LDP + C_NSAQ + 64 * hd, h, nullptr, 0.125f * LOG2E);
    const int nmax = (qpos - 31) >> 4, nml = (q0 + 63 - 31) >> 4, nt = nml < 0 ? 0 : (nml >> 6) + 1;
    float m = -1e30f, lsum = 0.f; f32x16 o[2]; o[0] = zero16(); o[1] = zero16();
    auto tr = [&](int i) { return 64 * i; }; auto mk = [&](int i, int& lo, int& hi) { lo = 0; hi = nmax - 64 * i; };
    flash_loop<1>(nt, tr, mk, kc, vc, 64, q, m, lsum, o, shm, tid, lane);
    lsum += __shfl_xor(lsum, 32); const float inv = lsum > 0.f ? 1.0f / lsum : 0.f;
    flash_loop<2>(nt, tr, mk, kc, vc, 64, q, m, lsum, o, shm, tid, lane, inv, imp, qloc);
    const float g0 = sigmoidf_(bf2f(p[(size_t)qpos * LDP + C_NGATE + hd * 3 + 0]));
    bf16_t* y = (bf16_t*)(P.ws + WS_Y + Y_NSA) + ((size_t)b * S_ + qpos) * 256 + 64 * hd;
#pragma unroll
    for (int dt = 0; dt < 2; ++dt)
#pragma unroll
        for (int gg = 0; gg < 4; ++gg) { const f32x16& a = o[dt]; *(u32x2*)(y + 32 * dt + 8 * gg + 4 * h) = (u32x2){cvt_pk_bf16(a[4 * gg] * g0, a[4 * gg + 1] * g0), cvt_pk_bf16(a[4 * gg + 2] * g0, a[4 * gg + 3] * g0)}; }
    __syncthreads();
    LAS float* scr = (LAS float*)(shm + A_MISC + 20480) + w * 64; unsigned long long* selm = (unsigned long long*)(P.ws + WS_Z3 + M_SEL) + (size_t)b * S_ + q0;
    const int cur = qt, j = lane;
    for (int qq = 8 * w; qq < 8 * w + 8; ++qq) {
        const bool forced = (j == 0) || (j == cur) || (j == cur - 1), valid = j <= cur;
        const float sc = forced ? 1e9f : (valid ? imp[qq * 65 + j] : -1e9f);
        scr[j] = sc; int rank = 0;
        for (int i = 0; i < 64; ++i) { const float si = scr[i]; rank += (si > sc || (si == sc && i < j)) ? 1 : 0; }
        const unsigned long long msk = __ballot(valid && rank < 16);
        if (lane == 0) selm[qq] = msk;
    }
    __syncthreads();
}

__device__ __forceinline__ void nsa_selwin_item(const Params& P, int it, LAS unsigned char* shm, int wv__) {
    const int tid = opaque_tid(wv__), lane = tid & 63, w = tid >> 6, r = lane & 31, h = lane >> 5;
    const int b = it & 7, qt = 63 - (it >> 3), q0 = 64 * qt;
    const bf16_t* p = (const bf16_t*)(P.ws + WS_R1) + (size_t)b * S_ * LDP; const f32x2* rope = (const f32x2*)(P.ws + WS_MISC + X_ROPE);
    const unsigned long long* selm = (const unsigned long long*)(P.ws + WS_Z3 + M_SEL) + (size_t)b * S_ + q0;
    const int hd = w >> 1, qsub = w & 1, qloc = 32 * qsub + r, qpos = q0 + qloc;
    LAS int* list = (LAS int*)(shm + A_MISC);
    unsigned long long un = selm[lane];
#pragma unroll
    for (int off = 1; off < 64; off <<= 1) { const unsigned lo = __shfl_xor((unsigned)un, off), hi = __shfl_xor((unsigned)(un >> 32), off); un |= ((unsigned long long)hi << 32) | lo; }
    const int nsel = __popcll(un);
    __syncthreads();
    if (tid == 0) { unsigned long long u = un; int k = 0; while (u) { list[k++] = __ffsll((long long)u) - 1; u &= u - 1; } }
    __syncthreads();
    const unsigned long long mysel = selm[qloc];
    QF q; load_q(q, p + (size_t)qpos * LDP + C_NSAQ + 64 * hd, h, rope + (size_t)qpos * 32, 0.125f * LOG2E);
    const float g1 = sigmoidf_(bf2f(p[(size_t)qpos * LDP + C_NGATE + hd * 3 + 1])), g2 = sigmoidf_(bf2f(p[(size_t)qpos * LDP + C_NGATE + hd * 3 + 2]));
    bf16_t* y = (bf16_t*)(P.ws + WS_Y + Y_NSA) + ((size_t)b * S_ + qpos) * 256 + 64 * hd;
    auto accum = [&](const f32x16 (&o)[2], float inv) {
#pragma unroll
        for (int dt = 0; dt < 2; ++dt)
#pragma unroll
            for (int gg = 0; gg < 4; ++gg) { u32x2* yp = (u32x2*)(y + 32 * dt + 8 * gg + 4 * h); const u32x2 c = *yp; const f32x16& a = o[dt];
                *yp = (u32x2){cvt_pk_bf16(a[4 * gg] * inv + bf_lo(c.x), a[4 * gg + 1] * inv + bf_hi(c.x)), cvt_pk_bf16(a[4 * gg + 2] * inv + bf_lo(c.y), a[4 * gg + 3] * inv + bf_hi(c.y))}; } };
    {
        float m = -1e30f, lsum = 0.f; f32x16 o[2]; o[0] = zero16(); o[1] = zero16();
        flash_loop<0>(nsel, [&](int i) { return 64 * list[i]; },
                      [&](int i, int& lo, int& hi) { const int j = list[i]; lo = 0; hi = ((mysel >> j) & 1ull) ? (qpos - 64 * j) : -1; },
                      p + C_KSLC, p + C_VSLC, LDP, q, m, lsum, o, shm, tid, lane);
        lsum += __shfl_xor(lsum, 32); accum(o, lsum > 0.f ? g1 / lsum : 0.f);
    }
    {
        float m = -1e30f, lsum = 0.f; f32x16 o[2]; o[0] = zero16(); o[1] = zero16();
        const int j0 = qt >= 8 ? qt - 8 : 0, nt = qt - j0 + 1;
        flash_loop<0>(nt, [&](int i) { return 64 * (j0 + i); }, [&](int i, int& lo, int& hi) { const int tb = 64 * (j0 + i); lo = qpos - 511 - tb; hi = qpos - tb; },
                      p + C_KWIN, p + C_VWIN, LDP, q, m, lsum, o, shm, tid, lane);
        lsum += __shfl_xor(lsum, 32); accum(o, g2 / lsum);
    }
    __syncthreads();
}

__device__ __forceinline__ float ret_log2g(int hd) { return log2f(1.0f - exp2f(-5.0f - (float)hd)); }
__device__ __forceinline__ void ret_kv_item(const Params& P, int it, LAS unsigned char* shm, int wv__) {
    const int tid = opaque_tid(wv__), lane = tid & 63, w = tid >> 6, r = lane & 31, h = lane >> 5;
    const int n = it & 31, hd = (it >> 5) & 3, b = it >> 7;
    const bf16_t* p = (const bf16_t*)(P.ws + WS_R1) + ((size_t)b * S_ + 128 * n) * LDP;
    LAS bf16_t* Kt = (LAS bf16_t*)shm; LAS bf16_t* Vt = (LAS bf16_t*)(shm + 17408);
    const float l2g = ret_log2g(hd);
    __syncthreads();
#pragma unroll
    for (int i = 0; i < 2; ++i) { const int task = tid + 512 * i, tok = task >> 3, c = task & 7; const u32x4 wv = *(const u32x4*)(p + (size_t)tok * LDP + C_RETK + 64 * hd + 8 * c);
        const float z = fast_exp2(l2g * (float)(127 - tok)); const unsigned ww[4] = {wv.x, wv.y, wv.z, wv.w}; LAS bf16_t* kt = Kt + (8 * c) * 136 + tok;
#pragma unroll
        for (int e = 0; e < 4; ++e) { const unsigned pk = cvt_pk_bf16(bf_lo(ww[e]) * z, bf_hi(ww[e]) * z); kt[(2 * e) * 136] = (bf16_t)(pk & 0xffff); kt[(2 * e + 1) * 136] = (bf16_t)(pk >> 16); } }
#pragma unroll
    for (int i = 0; i < 4; ++i) { const int task = tid + 512 * i, tok = task >> 4, c = task & 15; const u32x4 wv = *(const u32x4*)(p + (size_t)tok * LDP + C_RETV + 128 * hd + 8 * c);
        const unsigned ww[4] = {wv.x, wv.y, wv.z, wv.w}; LAS bf16_t* vt = Vt + (8 * c) * 136 + tok;
#pragma unroll
        for (int e = 0; e < 4; ++e) { vt[(2 * e) * 136] = (bf16_t)(ww[e] & 0xffff); vt[(2 * e + 1) * 136] = (bf16_t)(ww[e] >> 16); } }
    __syncthreads();
    const int et = w >> 1, dtile = w & 1; f32x16 acc = zero16();
#pragma unroll
    for (int s = 0; s < 8; ++s) { const bf16x8 a = *(const LAS bf16x8*)(Vt + (32 * et + r) * 136 + 16 * s + 8 * h), bb = *(const LAS bf16x8*)(Kt + (32 * dtile + r) * 136 + 16 * s + 8 * h); acc = mfma32(a, bb, acc); }
    bf16_t* kv = (bf16_t*)(P.ws + WS_Z3 + M_KV) + (size_t)it * 8192;
#pragma unroll
    for (int reg = 0; reg < 16; ++reg) { const int e = 32 * et + (reg & 3) + 8 * (reg >> 2) + 4 * h; kv[e * 64 + 32 * dtile + r] = (bf16_t)(cvt_pk_bf16(acc[reg], 0.f) & 0xffff); }
}

__device__ __forceinline__ void ret_out_item(const Params& P, int l, int it, LAS unsigned char* shm, int wv__) {
    const int tid = opaque_tid(wv__), lane = tid & 63, w = tid >> 6, r = lane & 31, h = lane >> 5;
    const int n = it & 31, hd = (it >> 5) & 3, b = it >> 7;
    const bf16_t* p = (const bf16_t*)(P.ws + WS_R1) + ((size_t)b * S_ + 128 * n) * LDP; const f32x2* rope = (const f32x2*)(P.ws + WS_MISC + X_ROPE);
    LAS bf16_t* Rt = (LAS bf16_t*)(shm + A_MISC); LAS f32x2* part = (LAS f32x2*)(shm + A_MISC + 18432);
    const float l2g = ret_log2g(hd), gch = fast_exp2(l2g * 128.0f);
    const int key = tid >> 3, c = tid & 7;
    u32x4 tk[2], tv0[2], tv1[2];
#pragma unroll
    for (int kt2 = 0; kt2 < 2; ++kt2) { const size_t off = (size_t)(64 * kt2 + key) * LDP;
        tk[kt2] = *(const u32x4*)(p + off + C_RETK + 64 * hd + 8 * c); tv0[kt2] = *(const u32x4*)(p + off + C_RETV + 128 * hd + 8 * c); tv1[kt2] = *(const u32x4*)(p + off + C_RETV + 128 * hd + 64 + 8 * c); }
    __syncthreads();
    {
        const bf16_t* kv = (const bf16_t*)(P.ws + WS_Z3 + M_KV) + (size_t)(it - n) * 8192 + tid * 16; f32x4 a[4];
#pragma unroll
        for (int i = 0; i < 4; ++i) a[i] = (f32x4){0.f, 0.f, 0.f, 0.f};
#pragma unroll 8
        for (int j = 0; j < n; ++j) { const u32x4* s = (const u32x4*)(kv + (size_t)j * 8192); const u32x4 s0 = s[0], s1 = s[1];
            a[0] = a[0] * gch + (f32x4){bf_lo(s0.x), bf_hi(s0.x), bf_lo(s0.y), bf_hi(s0.y)}; a[1] = a[1] * gch + (f32x4){bf_lo(s0.z), bf_hi(s0.z), bf_lo(s0.w), bf_hi(s0.w)};
            a[2] = a[2] * gch + (f32x4){bf_lo(s1.x), bf_hi(s1.x), bf_lo(s1.y), bf_hi(s1.y)}; a[3] = a[3] * gch + (f32x4){bf_lo(s1.z), bf_hi(s1.z), bf_lo(s1.w), bf_hi(s1.w)}; }
        const int e = tid >> 2, d0 = (tid & 3) * 16; LAS u32x4* dst = (LAS u32x4*)(Rt + e * 72 + d0);
        dst[0] = (u32x4){cvt_pk_bf16(a[0][0], a[0][1]), cvt_pk_bf16(a[0][2], a[0][3]), cvt_pk_bf16(a[1][0], a[1][1]), cvt_pk_bf16(a[1][2], a[1][3])};
        dst[1] = (u32x4){cvt_pk_bf16(a[2][0], a[2][1]), cvt_pk_bf16(a[2][2], a[2][3]), cvt_pk_bf16(a[3][0], a[3][1]), cvt_pk_bf16(a[3][2], a[3][3])};
    }
    const int qsub = w & 3, eh = w >> 2, qc = 32 * qsub + r, qpos = 128 * n + qc;
    QF q; load_q(q, p + (size_t)qc * LDP + C_RETQ + 64 * hd, h, rope + (size_t)qpos * 32, 0.125f);
    __syncthreads();
    f32x16 o[2];
#pragma unroll
    for (int dt = 0; dt < 2; ++dt) { o[dt] = zero16();
#pragma unroll
        for (int ks = 0; ks < 4; ++ks) { const bf16x8 a = *(const LAS bf16x8*)(Rt + (64 * eh + 32 * dt + r) * 72 + 16 * ks + 8 * h); o[dt] = mfma32(a, q.f[ks], o[dt]); }
        o[dt] = o[dt] * fast_exp2(l2g * (float)(qc + 1)); }
#pragma unroll
    for (int kt2 = 0; kt2 < 2; ++kt2) {
        const u32x4 kreg = tk[kt2], v0 = tv0[kt2], v1 = tv1[kt2];
        __syncthreads();
        store_kv_tile(shm, kreg, v0, key, c);
        { LAS bf16_t* vt = (LAS bf16_t*)(shm + A_VTS) + (64 + 8 * c) * 68 + key;
          vt[0] = (bf16_t)(v1.x & 0xffff); vt[68] = (bf16_t)(v1.x >> 16); vt[136] = (bf16_t)(v1.y & 0xffff); vt[204] = (bf16_t)(v1.y >> 16);
          vt[272] = (bf16_t)(v1.z & 0xffff); vt[340] = (bf16_t)(v1.z >> 16); vt[408] = (bf16_t)(v1.w & 0xffff); vt[476] = (bf16_t)(v1.w >> 16); }
        __syncthreads();
        if (64 * kt2 <= 32 * qsub + 31) {
            f32x16 s[2]; qk_tile(shm + A_KS, q, r, h, s);
#pragma unroll
            for (int kt = 0; kt < 2; ++kt)
#pragma unroll
                for (int reg = 0; reg < 16; ++reg) { const int kc_ = 64 * kt2 + 32 * kt + (reg & 3) + 8 * (reg >> 2) + 4 * h, diff = qc - kc_;
                    s[kt][reg] = diff >= 0 ? s[kt][reg] * fast_exp2(l2g * (float)diff) : 0.f; }
            pv_tile(shm + A_VTS, 64 * eh, s, r, h, o);
        }
    }
    float s1 = 0.f, s2 = 0.f;
#pragma unroll
    for (int dt = 0; dt < 2; ++dt)
#pragma unroll
        for (int e = 0; e < 16; ++e) { s1 += o[dt][e]; s2 += o[dt][e] * o[dt][e]; }
    s1 += __shfl_xor(s1, 32); s2 += __shfl_xor(s2, 32);
    if (h == 0) part[eh * 128 + qc] = (f32x2){s1, s2};
    __syncthreads();
    const f32x2 pa = part[qc], pb = part[128 + qc];
    const float mean = (pa.x + pb.x) * (1.0f / 128.0f), var = (pa.y + pb.y) * (1.0f / 128.0f) - mean * mean, rstd = rsqrtf(fmaxf(var, 0.f) + 1e-5f);
    const float* gn = P.in[I_GNG] + (size_t)l * 512 + 128 * hd;
    bf16_t* y = (bf16_t*)(P.ws + WS_Y + Y_RET) + ((size_t)b * S_ + qpos) * 512 + 128 * hd;
    const bf16_t* gin = p + (size_t)qc * LDP + C_RETG + 128 * hd;
#pragma unroll
    for (int dt = 0; dt < 2; ++dt)
#pragma unroll
        for (int gg = 0; gg < 4; ++gg) { const int e = 64 * eh + 32 * dt + 8 * gg + 4 * h; const f32x4 g4 = *(const f32x4*)(gn + e); const u32x2 gi = *(const u32x2*)(gin + e);
            const float gv[4] = {bf_lo(gi.x), bf_hi(gi.x), bf_lo(gi.y), bf_hi(gi.y)}; float ov[4];
#pragma unroll
            for (int i = 0; i < 4; ++i) { const float on = (o[dt][4 * gg + i] - mean) * rstd * g4[i]; ov[i] = gv[i] * sigmoidf_(gv[i]) * on; }
            *(u32x2*)(y + e) = (u32x2){cvt_pk_bf16(ov[0], ov[1]), cvt_pk_bf16(ov[2], ov[3])}; }
    __syncthreads();
}

template <int CTRL> __device__ __forceinline__ float dpp_add(float x) { return x + __builtin_bit_cast(float, __builtin_amdgcn_update_dpp(0, __builtin_bit_cast(int, x), CTRL, 0xf, 0xf, true)); }
__device__ __forceinline__ float reduce8(float x) { x = dpp_add<0xB1>(x); x = dpp_add<0x4E>(x); x = dpp_add<0x141>(x); return x; }
__device__ __forceinline__ float reduce16(float x) { x = reduce8(x); x = dpp_add<0x140>(x); return x; }
constexpr int R_R = 0, R_K = 8192, R_W = 16384, R_KK = 24576, R_KKA = 32768, R_A = 40960, R_VP = 49152, R_GP = 53248, R_YP = 57344, R_RK = 61440, R_ST = 61696,
              R_TW = 62720, R_AL = 67328, R_GL = 71936, R_W2 = 80640, R_A2 = 89856, R_G2 = 99072, R_END = 107776, R_V3X = 107776, R_RK2X = 113920;
__device__ __forceinline__ void rwkv_item(const Params& P, int l, int it, LAS unsigned char* shm, int wv__) {
    const int tid = opaque_tid(wv__), lane = tid & 63, w = tid >> 6, r = lane & 31, h = lane >> 5;
    const int chain = it >> 2, part = it & 3, b = chain >> 2, hd = chain & 3;
    const bf16_t* p = (const bf16_t*)(P.ws + WS_R1) + (size_t)b * S_ * LDP + C_RWKV;
    const float* mu = P.in[I_MU] + (size_t)l * 1024;
    LAS float* sR = (LAS float*)(shm + R_R); LAS float* sK = (LAS float*)(shm + R_K); LAS float* sW = (LAS float*)(shm + R_W);
    LAS float* sA = (LAS float*)(shm + R_A); LAS float* sKK = (LAS float*)(shm + R_KK); LAS float* sKKA = (LAS float*)(shm + R_KKA);
    LAS float* sVp = (LAS float*)(shm + R_VP); LAS float* sGp = (LAS float*)(shm + R_GP); LAS float* sYp = (LAS float*)(shm + R_YP);
    LAS float* sRK = (LAS float*)(shm + R_RK); LAS float* sST = (LAS float*)(shm + R_ST);
    LAS bf16_t* sTW = (LAS bf16_t*)(shm + R_TW); LAS bf16_t* sAL = (LAS bf16_t*)(shm + R_AL); LAS bf16_t* sGL = (LAS bf16_t*)(shm + R_GL);
    LAS bf16_t* W2t = (LAS bf16_t*)(shm + R_W2); LAS bf16_t* A2t = (LAS bf16_t*)(shm + R_A2); LAS bf16_t* G2t = (LAS bf16_t*)(shm + R_G2);
    __syncthreads();
    {
        const float* w2 = P.in[I_W2] + (size_t)l * 64 * 256 + 64 * hd; const float* a2 = P.in[I_A2] + (size_t)l * 64 * 256 + 64 * hd; const float* g2 = P.in[I_G2] + (size_t)l * 128 * 256 + 64 * hd + 16 * part;
        for (int e = tid; e < 4096; e += 512) { const int k = e >> 6, n = e & 63; W2t[n * 72 + k] = (bf16_t)(cvt_pk_bf16(w2[k * 256 + n], 0.f) & 0xffff); A2t[n * 72 + k] = (bf16_t)(cvt_pk_bf16(a2[k * 256 + n], 0.f) & 0xffff); }
        for (int e = tid; e < 4096; e += 512) { const int k = e >> 5, n = e & 31; G2t[n * 136 + k] = n < 16 ? (bf16_t)(cvt_pk_bf16(g2[k * 256 + n], 0.f) & 0xffff) : (bf16_t)0; }
    }
    const int t4 = tid & 255;
    int tcol[13], ttok[13];
#pragma unroll
    for (int i = 0; i < 8; ++i) { ttok[i] = (t4 >> 4) + 16 * (i & 1); tcol[i] = (i < 2 ? 64 * hd : i < 4 ? 256 + 64 * hd : i < 6 ? 768 : 832) + 4 * (t4 & 15); }
#pragma unroll
    for (int i = 8; i < 12; ++i) { ttok[i] = (t4 >> 5) + 8 * (i - 8); tcol[i] = 896 + 4 * (t4 & 31); }
    ttok[12] = t4 < 128 ? (t4 >> 2) : -1; tcol[12] = 512 + 64 * hd + 16 * part + 4 * (t4 & 3);
    u32x2 cur[13], prv[13];
    auto issue = [&](int ch) {
#pragma unroll
        for (int i = 0; i < 13; ++i) { const int t = 32 * ch + ttok[i]; cur[i] = (u32x2){0u, 0u}; prv[i] = (u32x2){0u, 0u};
            if (ttok[i] >= 0) { cur[i] = *(const u32x2*)(p + (size_t)t * LDP + tcol[i]); if (t > 0) prv[i] = *(const u32x2*)(p + (size_t)(t - 1) * LDP + tcol[i]); } } };
    LAS float* sR2 = (LAS float*)(shm + R_RK2X); LAS float* sK2 = sR2 + 2048; LAS float* sV3 = (LAS float*)(shm + R_V3X);
    auto stage_a = [&](int ch) {
        LAS float* dR = (ch & 1) ? sR2 : sR; LAS float* dK = (ch & 1) ? sK2 : sK; LAS float* dV = sV3 + (ch % 3) * 512;
#pragma unroll
        for (int i = 0; i < 13; ++i) if (ttok[i] >= 0) { const int tt = ttok[i], col = tcol[i]; const f32x4 m4 = *(const f32x4*)(mu + col);
            const float c0 = bf_lo(cur[i].x), c1 = bf_hi(cur[i].x), c2 = bf_lo(cur[i].y), c3 = bf_hi(cur[i].y);
            const float x0 = c0 + m4[0] * (bf_lo(prv[i].x) - c0), x1 = c1 + m4[1] * (bf_hi(prv[i].x) - c1), x2 = c2 + m4[2] * (bf_lo(prv[i].y) - c2), x3 = c3 + m4[3] * (bf_hi(prv[i].y) - c3);
            if (i < 2) *(LAS f32x4*)(dR + tt * 64 + (col & 63)) = (f32x4){x0, x1, x2, x3};
            else if (i < 4) *(LAS f32x4*)(dK + tt * 64 + (col & 63)) = (f32x4){x0, x1, x2, x3};
            else if (i == 12) *(LAS f32x4*)(dV + tt * 16 + (col & 15)) = (f32x4){x0, x1, x2, x3};
            else if (i < 6) *(LAS u32x2*)(sTW + tt * 72 + (col - 768)) = (u32x2){cvt_pk_bf16(fast_tanh(x0), fast_tanh(x1)), cvt_pk_bf16(fast_tanh(x2), fast_tanh(x3))};
            else if (i < 8) *(LAS u32x2*)(sAL + tt * 72 + (col - 832)) = (u32x2){cvt_pk_bf16(x0, x1), cvt_pk_bf16(x2, x3)};
            else *(LAS u32x2*)(sGL + tt * 136 + (col - 896)) = (u32x2){cvt_pk_bf16(fast_sigmoid(x0), fast_sigmoid(x1)), cvt_pk_bf16(fast_sigmoid(x2), fast_sigmoid(x3))}; } };
    const float w0v = P.in[I_W0][(size_t)l * 256 + 64 * hd + 32 * (w & 1) + r], a0v = P.in[I_A0][(size_t)l * 256 + 64 * hd + 32 * (w & 1) + r];
    f32x2 st01 = (f32x2){0.f, 0.f}, st23 = (f32x2){0.f, 0.f};
    const int srow = 4 * w + (lane >> 4), scg = lane & 15;
    const int ptok = tid >> 4, pl = tid & 15, pc = pl * 4, hc = 64 * hd + pc;
    const f32x4 kk4 = *(const f32x4*)(P.in[I_KK] + (size_t)l * 256 + hc), ka4 = *(const f32x4*)(P.in[I_KA] + (size_t)l * 256 + hc), rk4 = *(const f32x4*)(P.in[I_RK] + (size_t)l * 256 + hc);
    const int och = 64 * hd + 16 * part + pl;
    const float lng = P.in[I_LNG][(size_t)l * 256 + och], lnb = P.in[I_LNB][(size_t)l * 256 + och];
    bf16_t* yout = (bf16_t*)(P.ws + WS_Y + Y_RWKV) + (size_t)b * S_ * 256 + och; bf16_t* a1out = (bf16_t*)(P.ws + WS_Z3 + M_A1) + (size_t)b * S_ * 256 + och; bf16_t* a2out = (bf16_t*)(P.ws + WS_Z3 + M_A2) + (size_t)b * S_ * 256 + och;
    auto stage_b = [&](int ch) {
        if (w < 5) { const int mat = w >> 1, ntile = w & 1; f32x16 c = zero16(); const int chn = 32 * ntile + r;
            if (mat == 0) {
#pragma unroll
                for (int ks = 0; ks < 4; ++ks) c = mfma32(*(const LAS bf16x8*)(sTW + r * 72 + 16 * ks + 8 * h), *(const LAS bf16x8*)(W2t + chn * 72 + 16 * ks + 8 * h), c);
#pragma unroll
                for (int reg = 0; reg < 16; ++reg) { const int tok = (reg & 3) + 8 * (reg >> 2) + 4 * h; sW[tok * 64 + chn] = w0v + c[reg]; }
            } else if (mat == 1) {
#pragma unroll
                for (int ks = 0; ks < 4; ++ks) c = mfma32(*(const LAS bf16x8*)(sAL + r * 72 + 16 * ks + 8 * h), *(const LAS bf16x8*)(A2t + chn * 72 + 16 * ks + 8 * h), c);
#pragma unroll
                for (int reg = 0; reg < 16; ++reg) { const int tok = (reg & 3) + 8 * (reg >> 2) + 4 * h; sA[tok * 64 + chn] = a0v + c[reg]; }
            } else {
#pragma unroll
                for (int ks = 0; ks < 8; ++ks) c = mfma32(*(const LAS bf16x8*)(sGL + r * 136 + 16 * ks + 8 * h), *(const LAS bf16x8*)(G2t + r * 136 + 16 * ks + 8 * h), c);
                if (r < 16) {
#pragma unroll
                    for (int reg = 0; reg < 16; ++reg) { const int tok = (reg & 3) + 8 * (reg >> 2) + 4 * h; sGp[(ch & 1) * 512 + tok * 16 + r] = c[reg]; } }
            } } };
    auto stage_c = [&](int ch) {
        LAS float* bR = (ch & 1) ? sR2 : sR; LAS float* bK = (ch & 1) ? sK2 : sK;
        const f32x4 k = *(const LAS f32x4*)(bK + ptok * 64 + pc), araw = *(const LAS f32x4*)(sA + ptok * 64 + pc), wraw = *(const LAS f32x4*)(sW + ptok * 64 + pc), rr = *(const LAS f32x4*)(bR + ptok * 64 + pc);
        f32x4 a, dec;
#pragma unroll
        for (int e = 0; e < 4; ++e) { a[e] = fast_sigmoid(araw[e]); dec[e] = __expf(-0.6065306597126334f * fast_sigmoid(wraw[e])); }
        *(LAS f32x4*)(sW + ptok * 64 + pc) = dec;
        const f32x4 kkv = k * kk4; float ss = (kkv[0] * kkv[0] + kkv[1] * kkv[1]) + (kkv[2] * kkv[2] + kkv[3] * kkv[3]); ss = reduce16(ss);
        const float inv = __builtin_amdgcn_rcpf(fmaxf(sqrtf(ss), 1e-12f)); const f32x4 kk = kkv * inv; const f32x4 kp = k * (1.0f + (a - 1.0f) * ka4);
        float rk = (rr[0] * kp[0] * rk4[0] + rr[1] * kp[1] * rk4[1]) + (rr[2] * kp[2] * rk4[2] + rr[3] * kp[3] * rk4[3]); rk = reduce16(rk);
        *(LAS f32x4*)(sKK + ptok * 64 + pc) = kk; *(LAS f32x4*)(sKKA + ptok * 64 + pc) = kk * a; *(LAS f32x4*)(bK + ptok * 64 + pc) = kp;
        if (pl == 0) sRK[(ch & 1) * 32 + ptok] = rk; };
    auto stage_e = [&](int ch) {
#pragma unroll
        for (int i = 0; i < 2; ++i) { const int tk = (t4 >> 4) + 16 * i, q = (t4 & 15);
            const float y = sYp[(ch & 1) * 512 + tk * 16 + q], vv = sV3[(ch % 3) * 512 + tk * 16 + q], g = sGp[(ch & 1) * 512 + tk * 16 + q], rk = sRK[(ch & 1) * 32 + tk]; const size_t o = (size_t)(32 * ch + tk) * 256;
            yout[o] = (bf16_t)(cvt_pk_bf16(y, 0.f) & 0xffff); a1out[o] = (bf16_t)(cvt_pk_bf16(lng * g, 0.f) & 0xffff); a2out[o] = (bf16_t)(cvt_pk_bf16((lnb + rk * vv) * g, 0.f) & 0xffff); } };
    const int NCH = S_ / 32;
    if (w >= 4) { issue(0); stage_a(0); issue(1); }
    __syncthreads();
    stage_b(0); __syncthreads(); stage_c(0); __syncthreads();
    for (int ch = 0; ch < NCH; ++ch) {
        if (w < 4) {
            const LAS float* cK = (ch & 1) ? sK2 : sK; const LAS float* cR = (ch & 1) ? sR2 : sR;
            const LAS float* bw = sW + 4 * scg; const LAS float* bk = sKK + 4 * scg; const LAS float* ba = sKKA + 4 * scg; const LAS float* bp = cK + 4 * scg; const LAS float* br = cR + 4 * scg;
            const LAS float* bv = sV3 + (ch % 3) * 512 + srow; LAS float* by = sYp + (ch & 1) * 512 + srow;
            f32x4 nw = *(const LAS f32x4*)bw, nk = *(const LAS f32x4*)bk, na = *(const LAS f32x4*)ba, np = *(const LAS f32x4*)bp, nr = *(const LAS f32x4*)br; float nv = bv[0];
#pragma unroll 16
            for (int tt = 0; tt < 32; ++tt) {
                const f32x4 w4 = nw, k4 = nk, a4 = na, p4 = np, r4 = nr; const float v = nv;
                if (tt + 1 < 32) { const int o = (tt + 1) * 64; nw = *(const LAS f32x4*)(bw + o); nk = *(const LAS f32x4*)(bk + o); na = *(const LAS f32x4*)(ba + o); np = *(const LAS f32x4*)(bp + o); nr = *(const LAS f32x4*)(br + o); nv = bv[(tt + 1) * 16]; }
                f32x2 d = st01 * (f32x2){k4[0], k4[1]}; d = st23 * (f32x2){k4[2], k4[3]} + d;
                f32x2 u01 = st01 * (f32x2){w4[0], w4[1]} + (f32x2){p4[0], p4[1]} * v, u23 = st23 * (f32x2){w4[2], w4[3]} + (f32x2){p4[2], p4[3]} * v;
                const float sa = -reduce16(d.x + d.y);
                st01 = (f32x2){a4[0], a4[1]} * sa + u01; st23 = (f32x2){a4[2], a4[3]} * sa + u23;
                f32x2 yy = st01 * (f32x2){r4[0], r4[1]}; yy = st23 * (f32x2){r4[2], r4[3]} + yy;
                const float y = reduce16(yy.x + yy.y);
                if (scg == 0) by[tt * 16] = y;
            }
        } else {
            if (ch >= 1) stage_e(ch - 1);
            if (ch + 1 < NCH) { stage_a(ch + 1); if (ch + 2 < NCH) issue(ch + 2); }
        }
        __syncthreads();
        if (ch + 1 < NCH) { stage_b(ch + 1); __syncthreads(); stage_c(ch + 1); __syncthreads(); }
    }
    if (w >= 4) stage_e(NCH - 1);
    __syncthreads();
}

constexpr int LDS_BYTES = 147456, L_ITEM = 140000;
__device__ __forceinline__ void phase_cmp2(const Params& P, int l, int bid, int nb, int wv__) {
    const int ctid = opaque_tid(wv__);
    for (int o = bid * 512 + ctid; o < 2 * 2048 * 64; o += nb * 512) {
        const int kv = o >> 17, m = (o >> 6) & 2047, j = o & 63;
        const bf16_t* hrow = (const bf16_t*)(P.ws + WS_Z3 + (kv ? M_H1V : M_H1K)) + (size_t)m * 256;
        const float* w2 = P.in[kv ? I_CVW2 : I_CKW2] + (size_t)l * 256 * 64 + j; float s = 0.f;
#pragma unroll 4
        for (int i = 0; i < 256; i += 8) { const u32x4 hv = *(const u32x4*)(hrow + i); const unsigned ww[4] = {hv.x, hv.y, hv.z, hv.w};
#pragma unroll
            for (int e = 0; e < 4; ++e) { s += bf_lo(ww[e]) * w2[(size_t)(i + 2 * e) * 64]; s += bf_hi(ww[e]) * w2[(size_t)(i + 2 * e + 1) * 64]; } }
        ((bf16_t*)(P.ws + WS_Z3 + (kv ? M_VC : M_KC)))[(size_t)m * 64 + j] = (bf16_t)(cvt_pk_bf16(s, 0.f) & 0xffff);
    }
}


#ifdef PROF_SEL
#define STAMP(cat) do { if (bid == 0 && opaque_tid(wv__) == 0) { const long long now_ = wall_clock64(); LAS long long* pa_ = (LAS long long*)(shm + 141000); pa_[cat] += now_ - pa_[7]; pa_[7] = now_; } } while (0)
#else
#define STAMP(cat) do {} while (0)
#endif
__device__ __forceinline__ void phase_rwkv_ln(const Params& P, int bid, int nb, int wv__) {
    const int tid = opaque_tid(wv__);
    bf16_t* y = (bf16_t*)(P.ws + WS_Y + Y_RWKV); const bf16_t* a1 = (const bf16_t*)(P.ws + WS_Z3 + M_A1); const bf16_t* a2 = (const bf16_t*)(P.ws + WS_Z3 + M_A2);
    const int gs = nb * 512; int g = bid * 512 + tid;
    u32x2 nyw = (u32x2){0u, 0u}, np1 = nyw, np2 = nyw;
    if (g < T_ * 64) { const size_t o = (size_t)g * 4; nyw = *(const u32x2*)(y + o); np1 = *(const u32x2*)(a1 + o); np2 = *(const u32x2*)(a2 + o); }
    for (; g < T_ * 64; g += gs) {
        const size_t o = (size_t)g * 4; const u32x2 yw = nyw, p1 = np1, p2 = np2;
        if (g + gs < T_ * 64) { const size_t on = (size_t)(g + gs) * 4; nyw = *(const u32x2*)(y + on); np1 = *(const u32x2*)(a1 + on); np2 = *(const u32x2*)(a2 + on); }
        const float y0 = bf_lo(yw.x), y1 = bf_hi(yw.x), y2 = bf_lo(yw.y), y3 = bf_hi(yw.y);
        const float mean = reduce16((y0 + y1) + (y2 + y3)) * (1.0f / 64.0f); const float d0 = y0 - mean, d1 = y1 - mean, d2 = y2 - mean, d3 = y3 - mean;
        const float rstd = rsqrtf(reduce16((d0 * d0 + d1 * d1) + (d2 * d2 + d3 * d3)) * (1.0f / 64.0f) + 64e-5f);
        *(u32x2*)(y + o) = (u32x2){cvt_pk_bf16(d0 * rstd * bf_lo(p1.x) + bf_lo(p2.x), d1 * rstd * bf_hi(p1.x) + bf_hi(p2.x)), cvt_pk_bf16(d2 * rstd * bf_lo(p1.y) + bf_lo(p2.y), d3 * rstd * bf_hi(p1.y) + bf_hi(p2.y))};
    }
}
__device__ __forceinline__ void sub_barrier(unsigned* c, unsigned target, bool arrive, int wv__) {
    __syncthreads();
    if (opaque_tid(wv__) == 0) {
        if (arrive) { __builtin_amdgcn_fence(__ATOMIC_RELEASE, "agent"); __hip_atomic_fetch_add(c, 1u, __ATOMIC_RELAXED, __HIP_MEMORY_SCOPE_AGENT); }
        while (__hip_atomic_load(c, __ATOMIC_RELAXED, __HIP_MEMORY_SCOPE_AGENT) < target) __builtin_amdgcn_s_sleep(1);
        __builtin_amdgcn_fence(__ATOMIC_ACQUIRE, "agent");
    }
    __syncthreads();
}
__device__ __forceinline__ void phase_cb_reduce(const Params& P, int wv__) {
    const int t = opaque_tid(wv__); const float* pp = (const float*)(P.ws + WS_MISC + X_CBP) + (t >> 8) * 32 * 256 + (t & 255); float sacc = 0.f;
#pragma unroll 8
    for (int c = 0; c < 32; ++c) sacc += pp[c * 256];
    ((float*)(P.ws + WS_MISC + X_CB))[t] = sacc;
}
__global__ void __launch_bounds__(512, 2) fwd_megakernel(Params P) {
    extern __shared__ __attribute__((aligned(16))) unsigned char shm_raw[];
    LAS unsigned char* shm = (LAS unsigned char*)shm_raw;
    cg::grid_group grid = cg::this_grid();
    const int bid = blockIdx.x, nb = gridDim.x, wv__ = __builtin_amdgcn_readfirstlane(threadIdx.x >> 6);
#define ws (opq_ptr(P.ws))
#define W ((bf16_t*)(ws + WS_W))
#define H ((bf16_t*)(ws + WS_H))
#define R1 ((bf16_t*)(ws + WS_R1))
#define Fb ((bf16_t*)(ws + WS_R1 + R1_F))
#define Yb ((bf16_t*)(ws + WS_Y))
#define Z3 ((bf16_t*)(ws + WS_Z3))
#define ctr ((unsigned*)(ws + WS_MISC + X_CTR))
#ifdef PROF_SEL
    if (bid == 0 && opaque_tid(wv__) == 0) { LAS long long* pa_ = (LAS long long*)(shm + 141000); pa_[0] = pa_[1] = pa_[2] = pa_[3] = pa_[4] = pa_[5] = 0; pa_[7] = wall_clock64(); }
#endif
    unsigned gk = 0;
#define GSYNC() sub_barrier(ctr + 9, (unsigned)nb * (++gk), true, wv__)
    if (nb > (1 << 24)) grid.sync();
    phase_rowpass(P.in[I_X], nullptr, nullptr, 0.f, nullptr, P.in[I_F1PRE], H, bid, nb, wv__);
    phase_convert(P, 0, shm, bid, nb, wv__);
    GSYNC(); STAMP(4);
    for (int l = 0; l < 2; ++l) {
        run_gemm(shm, H, DM, W + W_GU1, T_, 5632, DM, EpiSwiGLU{R1}, nb, bid, wv__);
        GSYNC(); STAMP(0);
        run_gemm(shm, R1, FF, W + W_D1, T_, DM, FF, EpiPlain{Fb, DM}, nb, bid, wv__);
        GSYNC(); STAMP(0);
        if (bid == nb - 1) phase_cb_reduce(P, wv__);
        phase_rowpass(l == 0 ? P.in[I_X] : P.out, Fb, P.in[I_F1POST] + (size_t)l * DM, 0.5f, P.out, P.in[I_MPRE] + (size_t)l * DM, H, bid, nb, wv__);
        GSYNC(); STAMP(4);
        run_gemm(shm, H, DM, W + W_IN, T_, LDP, DM, EpiWin{R1, (bf16_t*)(ws + WS_Z3 + M_KCIN), (bf16_t*)(ws + WS_Z3 + M_VCIN), (const f32x2*)(ws + WS_MISC + X_ROPE)}, nb, bid, wv__);
        GSYNC(); STAMP(0);
        {
            const int NR = 128, NWK = nb - NR, wb = bid - NR; unsigned* sbc = ctr + 8;
            if (bid < NR) {
                rwkv_item(P, l, bid, shm, wv__);
                STAMP(1);
                sub_barrier(sbc, (unsigned)(NWK * (3 * l + 3)), false, wv__);
            } else {
                if (wb < 8) run_gemm(shm, (const bf16_t*)(ws + WS_Z3 + M_KCIN), 1024, W + W_CK1, 2048, 256, 2048, EpiGelu{(bf16_t*)(ws + WS_Z3 + M_H1K), (const float*)(ws + WS_MISC + X_CB)}, 8, wb, wv__);
                else if (wb < 16) run_gemm(shm, (const bf16_t*)(ws + WS_Z3 + M_VCIN), 1024, W + W_CV1, 2048, 256, 2048, EpiGelu{(bf16_t*)(ws + WS_Z3 + M_H1V), (const float*)(ws + WS_MISC + X_CB) + 256}, 8, wb - 8, wv__);
                if (NWK == 128) { const int x = wb & 7, j = (wb >> 3) - 2;
                    if (j >= 0) { for (int i = j; i < 128; i += 14) ret_kv_item(P, x * 128 + i, shm, wv__);
                                  for (int i = j; i < 64; i += 14) swa_item(P, l, x * 64 + i, shm, wv__); }
                } else for (int it = wb; it < 1536; it += NWK) { if (it < 1024) ret_kv_item(P, it, shm, wv__); else swa_item(P, l, it - 1024, shm, wv__); }
                sub_barrier(sbc, (unsigned)(NWK * (3 * l + 1)), true, wv__);
                phase_cmp2(P, l, wb, NWK, wv__);
                sub_barrier(sbc, (unsigned)(NWK * (3 * l + 2)), true, wv__);
                if (NWK == 128) { const int x = wb & 7, j = wb >> 3; for (int k = 0; k < 4; ++k) nsa_cmp_item(P, x * 64 + j + 16 * k, shm, wv__); }
                else for (int it = wb; it < 512; it += NWK) nsa_cmp_item(P, it, shm, wv__);
                sub_barrier(sbc, (unsigned)(NWK * (3 * l + 3)), true, wv__);
            }
        }
        for (int sx = 0; sx < 8; ++sx) {
            const int x = (bid + sx) & 7;
            const bool t0 = opaque_tid(wv__) == 0; int nextv = 0;
            if (t0) nextv = (int)atomicAdd(ctr + 32 + l * 8 + x, 1u);
            for (;;) {
                __syncthreads();
                if (t0) *(LAS int*)(shm + L_ITEM) = nextv;
                __syncthreads();
                const int idx = *(LAS int*)(shm + L_ITEM);
                if (idx >= 192) break;
                if (t0) nextv = (int)atomicAdd(ctr + 32 + l * 8 + x, 1u);
                if (idx < 64) nsa_selwin_item(P, x + 8 * idx, shm, wv__); else ret_out_item(P, l, x * 128 + (idx - 64), shm, wv__);
            }
        }
        STAMP(2);
        GSYNC(); STAMP(3);
        phase_rwkv_ln(P, bid, nb, wv__);
        GSYNC(); STAMP(3);
        {
            const int g1 = nb / 5, g2 = g1 + 2 * (nb / 5), g3 = g2 + nb / 5;
            if (bid < g1) run_gemm(shm, Yb, 256, W + W_PNSA, T_, DM, 256, EpiPlain{R1, DM}, g1, bid, wv__);
            else if (bid < g2) run_gemm(shm, (const bf16_t*)(ws + WS_Y + Y_RET), 512, W + W_PRET, T_, DM, 512, EpiPlain{R1 + (size_t)T_ * DM, DM}, g2 - g1, bid - g1, wv__);
            else if (bid < g3) run_gemm(shm, (const bf16_t*)(ws + WS_Y + Y_RWKV), 256, W + W_PRWKV, T_, DM, 256, EpiPlain{R1 + (size_t)2 * T_ * DM, DM}, g3 - g2, bid - g2, wv__);
            else run_gemm(shm, (const bf16_t*)(ws + WS_Y + Y_SWA), 256, W + W_PSWA, T_, DM, 256, EpiPlain{Z3, DM}, nb - g3, bid - g3, wv__);
        }
        GSYNC(); STAMP(0);
        run_gemm(shm, H, DM, W + W_GATE, T_, 4096, DM, EpiMerge{{R1, R1 + (size_t)T_ * DM, R1 + (size_t)2 * T_ * DM, Z3}, Yb}, nb, bid, wv__, 1);
        GSYNC(); STAMP(0);
        run_gemm(shm, Yb, DM, W + W_OUT, T_, DM, DM, EpiPlain{Fb, DM}, nb, bid, wv__);
        GSYNC(); STAMP(0);
        phase_rowpass(P.out, Fb, P.in[I_MPOST] + (size_t)l * DM, 1.0f, P.out, P.in[I_F2PRE] + (size_t)l * DM, H, bid, nb, wv__);
        GSYNC(); STAMP(4);
        run_gemm(shm, H, DM, W + W_GU2, T_, 5632, DM, EpiSwiGLU{R1}, nb, bid, wv__);
        GSYNC(); STAMP(0);
        run_gemm(shm, R1, FF, W + W_D2, T_, DM, FF, EpiPlain{Fb, DM}, nb, bid, wv__);
        GSYNC(); STAMP(0);
        phase_rowpass(P.out, Fb, P.in[I_F2POST] + (size_t)l * DM, 0.5f, P.out, l == 0 ? P.in[I_F1PRE] + DM : nullptr, H, bid, nb, wv__);
        if (l == 0) phase_convert(P, 1, shm, bid, nb, wv__);
        GSYNC(); STAMP(4);
    }
#ifdef PROF_SEL
    if (bid == 0) { __syncthreads(); LAS long long* pa_ = (LAS long long*)(shm + 141000); const double tot = (double)(pa_[0] + pa_[1] + pa_[2] + pa_[3] + pa_[4] + pa_[5]);
        const int Kp = (PROF_SEL >= 6) ? 200000 : (int)(200000.0 * (double)pa_[PROF_SEL] / tot); for (int e = opaque_tid(wv__); e < Kp; e += 512) P.out[e] += 0.5f; }
#endif
}
#undef ws
#undef W
#undef H
#undef R1
#undef Fb
#undef Yb
#undef Z3
#undef ctr
#undef GSYNC

extern "C" void kernel_launch(void* const* d_in, const int* in_sizes, int n_in, void* d_out, int out_size, void* d_ws, size_t ws_size, hipStream_t stream) {
    static int grid_blocks = 0;
    if (grid_blocks == 0) {
        if (n_in != N_IN || out_size != T_ * DM || ws_size < WS_END) { fprintf(stderr, "kernel_launch: unexpected shapes (n_in %d out %d ws %zu)\n", n_in, out_size, ws_size); grid_blocks = -1; return; }
        int dev = 0, cus = 0, per_cu = 0;
        hipGetDevice(&dev); hipDeviceGetAttribute(&cus, hipDeviceAttributeMultiprocessorCount, dev);
        hipFuncSetAttribute((const void*)fwd_megakernel, hipFuncAttributeMaxDynamicSharedMemorySize, LDS_BYTES);
        hipOccupancyMaxActiveBlocksPerMultiprocessor(&per_cu, (const void*)fwd_megakernel, 512, LDS_BYTES);
        if (per_cu < 1) per_cu = 1;
        grid_blocks = cus * per_cu;
        if (grid_blocks < 160) { fprintf(stderr, "kernel_launch: needs >= 160 co-resident workgroups\n"); grid_blocks = -1; return; }
    }
    if (grid_blocks < 0) return;
    hipMemsetAsync((char*)d_ws + WS_MISC + X_CTR, 0, 256 + 128 * 64, stream);
#ifdef REP_IDX
    hipMemsetAsync((char*)d_ws + WS_MISC + X_CTR + 64 + REP_IDX, 1, 1, stream);
#endif
    Params p{};
    for (int i = 0; i < N_IN; ++i) p.in[i] = (const float*)d_in[i];
    p.out = (float*)d_out; p.ws = (unsigned char*)d_ws;
    void* args[] = {&p};
    hipError_t e = hipLaunchCooperativeKernel((const void*)fwd_megakernel, dim3(grid_blocks), dim3(512), args, LDS_BYTES, stream);
    if (e != hipSuccess) fprintf(stderr, "cooperative launch failed: %s (grid %d)\n", hipGetErrorString(e), grid_blocks);
}
```
